# Optimizing an MI355X kernel written in HIP

```python
import math
import jax, jax.numpy as jnp
from jax import lax
import numpy as np

D_MODEL = 1024
BATCH = 16
SEQ = 2048
DEPTH = 4

N_EVEN = (DEPTH + 1) // 2
N_ODD = DEPTH // 2
EPS = 1e-6
N_MOD = 9

HEAD_DIM = 64
MIX_A_WIDTH = D_MODEL // 2
MIX_B_WIDTH = D_MODEL - MIX_A_WIDTH
A_HEADS = MIX_A_WIDTH // (2 * HEAD_DIM)
A_VDIM = 2 * HEAD_DIM
B_Q_HEADS = MIX_B_WIDTH // HEAD_DIM
B_KV_HEADS = 2
B_GROUP = B_Q_HEADS // B_KV_HEADS
WINDOW = 128
BLOCK = 128
NUM_BUCKETS = 32
MAX_DISTANCE = 128
N_ATTN_HEADS = A_HEADS + B_Q_HEADS

C_HEADS = 8
C_KDIM = D_MODEL // C_HEADS
C_VDIM = D_MODEL // C_HEADS
CHUNK = 32

D_FF = 2816

A_QK = A_HEADS * 2 * HEAD_DIM
A_V = A_HEADS * A_VDIM
B_Q = B_Q_HEADS * HEAD_DIM
B_KV = B_KV_HEADS * HEAD_DIM
EVEN_SPLITS = (A_QK, 2 * A_QK, 2 * A_QK + A_V, 2 * A_QK + A_V + B_Q, 2 * A_QK + A_V + B_Q + B_KV)
EVEN_IN = 2 * A_QK + A_V + B_Q + 2 * B_KV
EVEN_OUT = A_V + B_Q
C_HK = C_HEADS * C_KDIM
C_HV = C_HEADS * C_VDIM
ODD_SPLITS = (C_HK, 2 * C_HK, 3 * C_HK, 3 * C_HK + C_HV)
ODD_IN = 3 * C_HK + 2 * C_HV

kernel_name = "hybrid_diffattn_swa_hgrn2_macaron_encoder"


def rms_norm(x, g):
    xf = x.astype(jnp.float32)
    y = xf * lax.rsqrt(jnp.mean(xf * xf, axis=-1, keepdims=True) + EPS)
    return (y * g.astype(jnp.float32)).astype(x.dtype)


def modulate(h, shift, scale):
    return h * (1 + scale[:, None, :]) + shift[:, None, :]


def swiglu(h, w_up, w_down):
    a, b = jnp.split(h @ w_up, 2, axis=-1)
    return (jax.nn.silu(a) * b) @ w_down


def t5_bucket(rel):
    half = NUM_BUCKETS // 2
    max_exact = half // 2
    n = jnp.abs(rel)
    nf = jnp.maximum(n, 1).astype(jnp.float32)
    large = max_exact + (jnp.log(nf / max_exact) / math.log(MAX_DISTANCE / max_exact)
                         * (half - max_exact)).astype(jnp.int32)
    large = jnp.minimum(large, half - 1)
    return jnp.where(rel > 0, half, 0) + jnp.where(n < max_exact, n, large)


def diff_attention(q1, q2, k1, k2, v, lam, lam_init, table_a, subln_g):
    bsz, s = q1.shape[:2]
    nb = s // BLOCK
    scale = HEAD_DIM ** -0.5
    kpos = jnp.arange(s)

    def to_blocks(t):
        return jnp.moveaxis(t.reshape(bsz, nb, BLOCK, A_HEADS, HEAD_DIM), 1, 0)

    def block_fn(args):
        qb1, qb2, idx = args
        qpos = idx * BLOCK + jnp.arange(BLOCK)
        bias = jnp.transpose(table_a[t5_bucket(kpos[None, :] - qpos[:, None])], (2, 0, 1))
        bias = bias.astype(jnp.float32)
        s1 = jnp.einsum('bqhd,bkhd->bhqk', qb1, k1).astype(jnp.float32) * scale + bias
        s2 = jnp.einsum('bqhd,bkhd->bhqk', qb2, k2).astype(jnp.float32) * scale + bias
        p = jax.nn.softmax(s1, axis=-1) - lam * jax.nn.softmax(s2, axis=-1)
        return jnp.einsum('bhqk,bkhv->bqhv', p.astype(v.dtype), v)

    o = lax.map(block_fn, (to_blocks(q1), to_blocks(q2), jnp.arange(nb)))
    o = jnp.moveaxis(o, 0, 1).reshape(bsz, s, A_HEADS, A_VDIM)
    o = rms_norm(o, subln_g) * (1 - lam_init)
    return o.reshape(bsz, s, A_HEADS * A_VDIM)


def window_attention(q, k, v, sink, table_b):
    bsz, s = q.shape[:2]
    nb = s // BLOCK
    scale = HEAD_DIM ** -0.5
    qb = q.reshape(bsz, nb, BLOCK, B_KV_HEADS, B_GROUP, HEAD_DIM)

    def neighbours(t):
        tp = jnp.pad(t, ((0, 0), (BLOCK, BLOCK), (0, 0), (0, 0)))
        tp = tp.reshape(bsz, nb + 2, BLOCK, B_KV_HEADS, HEAD_DIM)
        return jnp.concatenate([tp[:, :-2], tp[:, 1:-1], tp[:, 2:]], axis=2)

    kn, vn = neighbours(k), neighbours(v)
    rel = jnp.arange(3 * BLOCK)[None, :] - BLOCK - jnp.arange(BLOCK)[:, None]
    kpos = (jnp.arange(nb)[:, None] - 1) * BLOCK + jnp.arange(3 * BLOCK)[None, :]
    valid = (jnp.abs(rel) <= WINDOW)[None] & ((kpos >= 0) & (kpos < s))[:, None, :]
    bias = jnp.transpose(table_b[t5_bucket(rel)], (2, 0, 1))
    bias = bias.reshape(B_KV_HEADS, B_GROUP, BLOCK, 3 * BLOCK).astype(jnp.float32)
    sc = jnp.einsum('bnqhgd,bnkhd->bnhgqk', qb, kn).astype(jnp.float32) * scale + bias
    sc = jnp.where(valid[None, :, None, None], sc, -jnp.inf)
    sk = sink.astype(jnp.float32).reshape(1, 1, B_KV_HEADS, B_GROUP, 1, 1)
    m = jnp.maximum(jnp.max(sc, axis=-1, keepdims=True), sk)
    e = jnp.exp(sc - m)
    p = e / (jnp.sum(e, axis=-1, keepdims=True) + jnp.exp(sk - m))
    o = jnp.einsum('bnhgqk,bnkhd->bnqhgd', p.astype(v.dtype), vn)
    return o.reshape(bsz, s, B_Q_HEADS * HEAD_DIM)


def even_mixer(h, w_in, w_out, qk_g, lam_p, subln_g, sink, rel_bias, layer_idx):
    bsz, s, _ = h.shape
    aq, ak, av, bq, bk, bv = jnp.split(h @ w_in, EVEN_SPLITS, axis=-1)
    aq = rms_norm(aq.reshape(bsz, s, A_HEADS, 2, HEAD_DIM), qk_g[0])
    ak = rms_norm(ak.reshape(bsz, s, A_HEADS, 2, HEAD_DIM), qk_g[1])
    av = av.reshape(bsz, s, A_HEADS, A_VDIM)
    lam_init = 0.8 - 0.6 * math.exp(-0.3 * layer_idx)
    lp = lam_p.astype(jnp.float32)
    lam = jnp.exp(jnp.sum(lp[0] * lp[1])) - jnp.exp(jnp.sum(lp[2] * lp[3])) + lam_init
    ya = diff_attention(aq[..., 0, :], aq[..., 1, :], ak[..., 0, :], ak[..., 1, :], av,
                        lam, lam_init, rel_bias[:, :A_HEADS], subln_g)
    bq = rms_norm(bq.reshape(bsz, s, B_Q_HEADS, HEAD_DIM), qk_g[2])
    bk = rms_norm(bk.reshape(bsz, s, B_KV_HEADS, HEAD_DIM), qk_g[3])
    bv = bv.reshape(bsz, s, B_KV_HEADS, HEAD_DIM)
    yb = window_attention(bq, bk, bv, sink, rel_bias[:, A_HEADS:])
    return jnp.concatenate([ya, yb], axis=-1) @ w_out


def chunk_gla(q, k, v, log_f):
    n, s, h, dk = q.shape
    dv = v.shape[-1]
    nc = s // CHUNK

    def chunks(t):
        return jnp.moveaxis(t.reshape(n, nc, CHUNK, h, t.shape[-1]), 1, 0)

    g_cum = jnp.cumsum(chunks(log_f), axis=2)
    causal = jnp.tril(jnp.ones((CHUNK, CHUNK), dtype=bool))[None, :, :, None, None]

    def step(state, inp):
        qc, kc, vc, gc = inp
        decay = jnp.exp(jnp.where(causal, gc[:, :, None] - gc[:, None], -jnp.inf))
        attn = jnp.einsum('ntshd,nshd->nhts', qc[:, :, None] * decay, kc)
        o = jnp.einsum('nhts,nshv->nthv', attn, vc) + jnp.einsum('nthd,nhdv->nthv', qc * jnp.exp(gc), state)
        g_last = gc[:, -1]
        state = jnp.exp(g_last)[..., None] * state + jnp.einsum(
            'nshd,nshv->nhdv', kc * jnp.exp(g_last[:, None] - gc), vc)
        return state, o

    s0 = jnp.zeros((n, h, dk, dv), jnp.float32)
    _, o = lax.scan(step, s0, (chunks(q), chunks(k), chunks(v), g_cum))
    return jnp.moveaxis(o, 0, 1).reshape(n, s, h, dv)


def log_forget(f_raw, lb):
    lb = lb.reshape(C_HEADS, C_KDIM)
    return jnp.logaddexp(jnp.log(lb), jnp.log1p(-lb) + jax.nn.log_sigmoid(f_raw.astype(jnp.float32)))


def hgrn2_bidirectional(q, i_in, log_f_fwd, log_f_bwd):
    bsz = q.shape[0]
    flip = lambda t: jnp.flip(t, axis=1)
    qq = jnp.concatenate([q, flip(q)], axis=0).astype(jnp.float32)
    vv = jnp.concatenate([i_in, flip(i_in)], axis=0).astype(jnp.float32)
    lf = jnp.concatenate([log_f_fwd, flip(log_f_bwd)], axis=0)
    kk = -jnp.expm1(lf)
    o = chunk_gla(qq, kk, vv, lf)
    return o[:bsz] + flip(o[bsz:])


def odd_mixer(h, w_in, w_out, lb, out_g):
    bsz, s, _ = h.shape
    q, ff, fb, iv, g = jnp.split(h @ w_in, ODD_SPLITS, axis=-1)
    heads_k = lambda t: t.reshape(bsz, s, C_HEADS, C_KDIM)
    heads_v = lambda t: t.reshape(bsz, s, C_HEADS, C_VDIM)
    o = hgrn2_bidirectional(jax.nn.silu(heads_k(q)), heads_v(iv),
                            log_forget(heads_k(ff), lb[0]), log_forget(heads_k(fb), lb[1]))
    o = rms_norm(o.astype(h.dtype), out_g) * jax.nn.silu(heads_v(g))
    return o.reshape(bsz, s, C_HV) @ w_out


def setup_inputs(seed: int = 0) -> dict:
    key = jax.random.key(seed)
    ks = jax.random.split(key, 18)
    nrm = lambda k, shape, sc: jax.random.normal(k, shape, jnp.float32) * sc
    return {
        "x": nrm(ks[0], (BATCH, SEQ, D_MODEL), 1.0),
        "c": nrm(ks[1], (BATCH, D_MODEL), 1.0),
        "ada_w": nrm(ks[2], (DEPTH, D_MODEL, N_MOD * D_MODEL), 0.5 * D_MODEL ** -0.5),
        "ada_b": nrm(ks[3], (DEPTH, N_MOD * D_MODEL), 0.02),
        "norm_g": 1.0 + nrm(ks[4], (DEPTH, 3, D_MODEL), 0.02),
        "ffn_up": nrm(ks[5], (DEPTH, 2, D_MODEL, 2 * D_FF), D_MODEL ** -0.5),
        "ffn_down": nrm(ks[6], (DEPTH, 2, D_FF, D_MODEL), D_FF ** -0.5),
        "even_w_in": nrm(ks[7], (N_EVEN, D_MODEL, EVEN_IN), D_MODEL ** -0.5),
        "even_w_out": nrm(ks[8], (N_EVEN, EVEN_OUT, D_MODEL), EVEN_OUT ** -0.5),
        "qk_norm_g": 1.0 + nrm(ks[9], (N_EVEN, 4, HEAD_DIM), 0.02),
        "diff_lambda": nrm(ks[10], (N_EVEN, 4, HEAD_DIM), 0.1),
        "diff_subln_g": 1.0 + nrm(ks[11], (N_EVEN, A_VDIM), 0.02),
        "sink_logit": nrm(ks[12], (N_EVEN, B_Q_HEADS), 0.5),
        "rel_bias": nrm(ks[13], (NUM_BUCKETS, N_ATTN_HEADS), 0.1),
        "odd_w_in": nrm(ks[14], (N_ODD, D_MODEL, ODD_IN), D_MODEL ** -0.5),
        "odd_w_out": nrm(ks[15], (N_ODD, C_HV, D_MODEL), C_HV ** -0.5),
        "c_lower_bound": nrm(ks[16], (2, DEPTH, C_HK), 0.1),
        "c_out_norm_g": 1.0 + nrm(ks[17], (N_ODD, C_VDIM), 0.02),
    }


def reference(x, c, ada_w, ada_b, norm_g, ffn_up, ffn_down, even_w_in, even_w_out, qk_norm_g,
              diff_lambda, diff_subln_g, sink_logit, rel_bias, odd_w_in, odd_w_out,
              c_lower_bound, c_out_norm_g):
    mod_all = jnp.einsum('bd,ldm->lbm', jax.nn.silu(c), ada_w) + ada_b[:, None, :]
    sm = jax.nn.softmax(c_lower_bound.astype(jnp.float32), axis=1)
    lb_all = jnp.cumsum(sm, axis=1) - sm[:, :1]
    for l in range(DEPTH):
        sh1, sc1, g1, sh2, sc2, g2, sh3, sc3, g3 = jnp.split(mod_all[l], N_MOD, axis=-1)
        h = modulate(rms_norm(x, norm_g[l, 0]), sh1, sc1)
        x = x + 0.5 * g1[:, None, :] * swiglu(h, ffn_up[l, 0], ffn_down[l, 0])
        h = modulate(rms_norm(x, norm_g[l, 1]), sh2, sc2)
        if l % 2 == 0:
            e = l // 2
            y = even_mixer(h, even_w_in[e], even_w_out[e], qk_norm_g[e], diff_lambda[e],
                           diff_subln_g[e], sink_logit[e], rel_bias, l)
        else:
            o = l // 2
            y = odd_mixer(h, odd_w_in[o], odd_w_out[o], lb_all[:, l], c_out_norm_g[o])
        x = x + g2[:, None, :] * y
        h = modulate(rms_norm(x, norm_g[l, 2]), sh3, sc3)
        x = x + 0.5 * g3[:, None, :] * swiglu(h, ffn_up[l, 1], ffn_down[l, 1])
    return x
```

```cpp
#include <hip/hip_runtime.h>
#include <hip/hip_cooperative_groups.h>
#include <cstdio>
namespace cg = cooperative_groups;
namespace pg8 {
#define PG8_LAS __attribute__((address_space(3)))
typedef unsigned short bf16_t;
typedef short bf16x8 __attribute__((ext_vector_type(8)));
typedef float f32x4 __attribute__((ext_vector_type(4)));
typedef unsigned u32x4 __attribute__((ext_vector_type(4)));
constexpr int BM = 256, BK = 64, HALF = 128, HTB = HALF * BK * 2  , STAGE_BYTES = 8 * HTB, NXCD = 8, WGM = 8;

__host__ __device__ __forceinline__ int lds_byte(int r, int c) { const int st = (r >> 4) * 2 + (c >> 5), rr = r & 15, cc = c & 31, ob = rr * 64 + cc * 2; return st * 1024 + (ob ^ (((ob >> 9) & 1) << 5)); }
__host__ __device__ __forceinline__ void stage_rc(int b, int& R, int& C) { const int st = b / 1024, sb = b % 1024, swz = sb ^ (((sb >> 9) & 1) << 5); R = (st >> 1) * 16 + swz / 64; C = (st & 1) * 32 + (swz % 64) / 2; }
__host__ __device__ __forceinline__ int perm32(int rho) { const int n = rho >> 4, i = rho & 15; return 8 * (i >> 2) + 4 * n + (i & 3); }

struct Unit { int pm, pn; };
struct Gemm { const bf16_t* A; const bf16_t* Bt; int M, N, K; };

struct StaticOrder {
    int nM, nN, nwg, G, c;
    __host__ __device__ void init(int M, int N, int G_, int c_) { nM = M / BM; nN = N / BM; nwg = nM * nN; G = G_; c = c_; }
    __host__ __device__ bool next(int i, Unit& u) const {
        const long L = (long)i * G + c; if (L >= nwg) return false;
        int wgid = (int)L; { const int q = nwg / NXCD, r = nwg % NXCD, xcd = wgid % NXCD, off = wgid / NXCD; wgid = (xcd < r ? xcd * (q + 1) : r * (q + 1) + (xcd - r) * q) + off; }
        const int nig = WGM * nN, gid = wgid / nig, fm = gid * WGM, gsz = (nM - fm) < WGM ? (nM - fm) : WGM;
        u.pm = fm + ((wgid % nig) % gsz); u.pn = (wgid % nig) / gsz; return true;
    }
    __device__ __forceinline__ void a_ready(const Unit&) const {}
    __device__ __forceinline__ void done(const Unit&) const {}
};
__device__ __forceinline__ unsigned cvt_pk_bf16(float lo, float hi) { unsigned r; asm volatile("v_cvt_pk_bf16_f32 %0, %1, %2" : "=v"(r) : "v"(lo), "v"(hi)); return r; }
typedef float f32x2 __attribute__((ext_vector_type(2)));
template <class Epi, class Sched, bool STAMP = false>
__device__ __forceinline__ void gemm_phase(PG8_LAS unsigned char* lds, const Gemm g, const Sched& S, const Epi& E, unsigned long long* stamps, const int tid) {
    const int wid = __builtin_amdgcn_readfirstlane(tid >> 6), lane = tid & 63, wr = wid >> 2, wc = wid & 3, fr = lane & 15, fq = lane >> 4;
    const int K = g.K, nt = K / BK;
    int ts_lo = 0, ts_hi = 0, nts = 0; const unsigned long long rt_entry = STAMP ? (unsigned long long)wall_clock64() : 0ull;
#define PG8_STAMP() do { if (STAMP && wid == 0 && nts < 64) { const unsigned long long _c = (unsigned long long)clock64(); \
        ts_lo = (lane == nts) ? (int)(unsigned)_c : ts_lo; ts_hi = (lane == nts) ? (int)(unsigned)(_c >> 32) : ts_hi; ++nts; } } while (0)
    PG8_STAMP();
    unsigned voffA[2], voffB[2];
#pragma unroll
    for (int i = 0; i < 2; ++i) { int R, C; stage_rc(tid * 16 + i * 8192, R, C); const int Rb = Epi::PERM ? ((R & ~31) + perm32(R & 31)) : R;
        voffA[i] = (unsigned)(R * K + C) * 2u; voffB[i] = (unsigned)(Rb * K + C) * 2u; }
    const size_t kstep = (size_t)(BK * 2);
    const size_t hstep = (size_t)HALF * K * 2;
    const size_t tstep = 2 * hstep;
    const unsigned ldsw = (unsigned)wid * 1024u;
    const int aoff = lds_byte(wr * 64 + fr, fq * 8), boff = lds_byte(wc * 32 + fr, fq * 8);
#define PG8_SA(b, h) (((b) * 2 + (h)) * HTB)
#define PG8_SB(b, h) ((4 + (b) * 2 + (h)) * HTB)
#define PG8_STAGE(bufoff, gbase, voff) do { _Pragma("unroll") for (int _i = 0; _i < 2; ++_i) \
        __builtin_amdgcn_global_load_lds((const unsigned*)((const char*)(gbase) + (voff)[_i]), (PG8_LAS unsigned*)(lds + (bufoff) + ldsw + _i * 8192), 16, 0, 0); } while (0)
#define PG8_LDA(dst, b, h) do { _Pragma("unroll") for (int m = 0; m < 4; ++m) _Pragma("unroll") for (int k = 0; k < 2; ++k) dst[m][k] = *(const PG8_LAS bf16x8*)(lds + PG8_SA(b, h) + aoff + m * 2048 + k * 1024); } while (0)
#define PG8_LDB(dst, b, h) do { _Pragma("unroll") for (int n = 0; n < 2; ++n) _Pragma("unroll") for (int k = 0; k < 2; ++k) dst[n][k] = *(const PG8_LAS bf16x8*)(lds + PG8_SB(b, h) + boff + n * 2048 + k * 1024); } while (0)
#define PG8_MMA(ai, bj, At, Bt) do { __builtin_amdgcn_s_setprio(1); _Pragma("unroll") for (int m = 0; m < 4; ++m) _Pragma("unroll") for (int n = 0; n < 2; ++n) _Pragma("unroll") for (int k = 0; k < 2; ++k) \
        acc[ai][bj][m][n] = __builtin_amdgcn_mfma_f32_16x16x32_bf16(Bt[n][k], At[m][k], acc[ai][bj][m][n], 0, 0, 0); __builtin_amdgcn_s_setprio(0); } while (0)
#define PG8_WAIT_V(n) asm volatile("s_waitcnt vmcnt(" #n ")" ::: "memory")
#define PG8_WAIT_L(n) asm volatile("s_waitcnt lgkmcnt(" #n ")" ::: "memory")
#define PG8_BAR __builtin_amdgcn_s_barrier()
#define PG8_SCHED __builtin_amdgcn_sched_barrier(0)
    Unit cur, nxt; int ui = 0;
    if (!S.next(0, cur)) return;
    f32x4 acc[2][2][4][2];
#pragma unroll
    for (int a = 0; a < 2; ++a)
#pragma unroll
        for (int b = 0; b < 2; ++b)
#pragma unroll
            for (int m = 0; m < 4; ++m)
#pragma unroll
                for (int n = 0; n < 2; ++n) acc[a][b][m][n] = (f32x4){0.f, 0.f, 0.f, 0.f};
    bf16x8 At[4][2], B0[2][2], B1[2][2];
    const char* cA = (const char*)g.A + (size_t)cur.pm * tstep; const char* cB = (const char*)g.Bt + (size_t)cur.pn * tstep;
    S.a_ready(cur);
    PG8_STAGE(PG8_SB(0, 0), cB, voffB); PG8_STAGE(PG8_SA(0, 0), cA, voffA); PG8_STAGE(PG8_SB(0, 1), cB + hstep, voffB); PG8_STAGE(PG8_SA(0, 1), cA + hstep, voffA);
    if (wr == 1) PG8_BAR;
    PG8_WAIT_V(4); PG8_BAR;
    PG8_STAGE(PG8_SB(1, 0), cB + kstep, voffB); PG8_STAGE(PG8_SA(1, 0), cA + kstep, voffA); PG8_STAGE(PG8_SB(1, 1), cB + hstep + kstep, voffB);
    PG8_WAIT_V(6); PG8_BAR;
    PG8_STAMP();
    for (;;) {
        const bool has_next = S.next(ui + 1, nxt);
        const char* nA = has_next ? (const char*)g.A + (size_t)nxt.pm * tstep : cA; const char* nB = has_next ? (const char*)g.Bt + (size_t)nxt.pn * tstep : cB;
        for (int t = 0; t < nt; t += 2) {
            const bool last = (t == nt - 2);
            const char* a1 = cA + (size_t)(t + 1) * kstep;
            const char* a2 = last ? nA : cA + (size_t)(t + 2) * kstep; const char* b2 = last ? nB : cB + (size_t)(t + 2) * kstep;
            const char* a3 = a2 + kstep; const char* b3 = b2 + kstep;
            if (last && has_next) S.a_ready(nxt);
            PG8_LDB(B0, 0, 0); PG8_SCHED; PG8_LDA(At, 0, 0); PG8_STAGE(PG8_SA(1, 1), a1 + hstep, voffA);
            PG8_WAIT_L(8); PG8_BAR; PG8_WAIT_L(0); PG8_MMA(0, 0, At, B0); PG8_BAR; PG8_SCHED;
            PG8_LDB(B1, 0, 1); PG8_STAGE(PG8_SB(0, 0), b2, voffB);
            PG8_BAR; PG8_WAIT_L(0); PG8_MMA(0, 1, At, B1); PG8_BAR;
            PG8_LDA(At, 0, 1); PG8_STAGE(PG8_SA(0, 0), a2, voffA);
            PG8_BAR; PG8_WAIT_L(0); PG8_MMA(1, 0, At, B0); PG8_BAR; PG8_SCHED;
            PG8_STAGE(PG8_SB(0, 1), b2 + hstep, voffB);
            PG8_WAIT_V(6); PG8_BAR; PG8_MMA(1, 1, At, B1); PG8_BAR;
            PG8_LDB(B0, 1, 0); PG8_SCHED; PG8_LDA(At, 1, 0); PG8_STAGE(PG8_SA(0, 1), a2 + hstep, voffA);
            PG8_WAIT_L(8); PG8_BAR; PG8_WAIT_L(0); PG8_MMA(0, 0, At, B0); PG8_BAR; PG8_SCHED;
            PG8_LDB(B1, 1, 1); PG8_STAGE(PG8_SB(1, 0), b3, voffB);
            PG8_BAR; PG8_WAIT_L(0); PG8_MMA(0, 1, At, B1); PG8_BAR;
            PG8_LDA(At, 1, 1); PG8_STAGE(PG8_SA(1, 0), a3, voffA);
            PG8_BAR; PG8_WAIT_L(0); PG8_MMA(1, 0, At, B0); PG8_BAR; PG8_SCHED;
            PG8_STAGE(PG8_SB(1, 1), b3 + hstep, voffB);
            PG8_WAIT_V(6); PG8_BAR; PG8_MMA(1, 1, At, B1); PG8_BAR;
        }
        PG8_STAMP();
        if constexpr (!Epi::AFTER_DRAIN) { E(acc, cur, wr, wc, fr, fq); S.done(cur); }
        PG8_STAMP();
        if (!has_next) break;
#pragma unroll
        for (int a = 0; a < 2; ++a)
#pragma unroll
            for (int b = 0; b < 2; ++b)
#pragma unroll
                for (int m = 0; m < 4; ++m)
#pragma unroll
                    for (int n = 0; n < 2; ++n) acc[a][b][m][n] = (f32x4){0.f, 0.f, 0.f, 0.f};
        cur = nxt; cA = nA; cB = nB; ++ui;
    }
    PG8_WAIT_V(0);
    if (wr == 0) PG8_BAR;
    PG8_BAR;
    if constexpr (Epi::AFTER_DRAIN) { E.fused(acc, cur, wr, wc, fr, fq, lds, wid, lane); S.done(cur); }
    PG8_STAMP();
    if (STAMP && wid == 0) { stamps[lane] = lane < nts ? (((unsigned long long)(unsigned)ts_hi << 32) | (unsigned)ts_lo) : 0ull;
        if (lane == 62) stamps[62] = rt_entry; if (lane == 63) stamps[63] = (unsigned long long)wall_clock64(); }
#undef PG8_STAMP
#undef PG8_SA
#undef PG8_SB
#undef PG8_STAGE
#undef PG8_LDA
#undef PG8_LDB
#undef PG8_MMA
#undef PG8_WAIT_V
#undef PG8_WAIT_L
#undef PG8_BAR
#undef PG8_SCHED
}
}

#define LAS __attribute__((address_space(3)))
using pg8::bf16_t; using pg8::bf16x8; using pg8::f32x4; using pg8::u32x4; using pg8::cvt_pk_bf16;
typedef short s16x4 __attribute__((ext_vector_type(4)));
typedef float f32x2 __attribute__((ext_vector_type(2)));
typedef float f32x16 __attribute__((ext_vector_type(16)));
typedef unsigned u32x2 __attribute__((ext_vector_type(2)));

constexpr int M_TOK = 32768, DM = 1024, SEQ = 2048, FF = 2816, NUP = 5632, EIN = 2304, OIN = 5120, NMOD = 9216;
constexpr float EPS = 1e-6f, LOG2E = 1.4426950408889634f;
constexpr int LDS_BYTES = 147456;
constexpr int N_PHASES = 45;

constexpr size_t al256(size_t x) { return (x + 255) & ~(size_t)255; }
constexpr size_t WS_MOD = 0;
constexpr size_t WS_WUP = al256(WS_MOD + 4ull * 16 * NMOD * 4);
constexpr size_t WS_WDN = WS_WUP + 8ull * NUP * DM * 2;
constexpr size_t WS_WEIN = WS_WDN + 8ull * DM * FF * 2;
constexpr size_t WS_WEOUT = WS_WEIN + 2ull * EIN * DM * 2;
constexpr size_t WS_WOIN = WS_WEOUT + 2ull * DM * DM * 2;
constexpr size_t WS_WOOUT = WS_WOIN + 2ull * OIN * DM * 2;
constexpr size_t WS_H = WS_WOOUT + 2ull * DM * DM * 2;
constexpr size_t WS_Y = WS_H + (size_t)M_TOK * DM * 2;
constexpr size_t WS_R1 = WS_Y + (size_t)M_TOK * DM * 2;
constexpr size_t WS_O1 = WS_R1 + (size_t)M_TOK * OIN * 2;
constexpr size_t WS_END = WS_O1 + 512ull * 8 * 16 * 64 * 16;

struct Params {
    const float *x, *c, *ada_w, *ada_b, *norm_g, *ffn_up, *ffn_down, *even_w_in, *even_w_out, *qk_norm_g, *diff_lambda, *diff_subln_g, *sink_logit, *rel_bias,
        *odd_w_in, *odd_w_out, *c_lower_bound, *c_out_norm_g;
    float* out; unsigned char* ws; int ph_lo, ph_hi;
};

__device__ __forceinline__ float bf_lo(unsigned u) { return __uint_as_float(u << 16); }
__device__ __forceinline__ float bf_hi(unsigned u) { return __uint_as_float(u & 0xffff0000u); }
__device__ __forceinline__ float wave_sum(float v) {
#pragma unroll
    for (int o = 1; o < 64; o <<= 1) v += __shfl_xor(v, o);
    return v;
}
__device__ __forceinline__ float ex2(float v) { return __builtin_amdgcn_exp2f(v); }
__device__ __forceinline__ float silu_f(float a) { return a * __builtin_amdgcn_rcpf(1.f + ex2(-a * LOG2E)); }
__device__ __forceinline__ float sigm_f(float a) { return __builtin_amdgcn_rcpf(1.f + ex2(-a * LOG2E)); }

struct EpiMulti {
    static constexpr bool PERM = true, AFTER_DRAIN = false;
    int mode; bf16_t* O; int ldc; const float* base; float* out; const float* gate; float coef;
    __device__ __forceinline__ void operator()(const f32x4 (&acc)[2][2][4][2], const pg8::Unit& u, int wr, int wc, int fr, int fq) const {
        const int row0 = u.pm * 256 + wr * 64 + fr;
        if (mode == 0) {
            const int col0 = u.pn * 128 + wc * 32 + 8 * fq;
#pragma unroll
            for (int ai = 0; ai < 2; ++ai)
#pragma unroll
                for (int m = 0; m < 4; ++m) {
                    bf16_t* rowp = O + (size_t)(row0 + ai * 128 + m * 16) * FF + col0;
                    const f32x4 a0 = acc[ai][0][m][0], a1 = acc[ai][0][m][1], b0 = acc[ai][1][m][0], b1 = acc[ai][1][m][1];
                    u32x4 w;
                    w.x = cvt_pk_bf16(silu_f(a0[0]) * b0[0], silu_f(a0[1]) * b0[1]); w.y = cvt_pk_bf16(silu_f(a0[2]) * b0[2], silu_f(a0[3]) * b0[3]);
                    w.z = cvt_pk_bf16(silu_f(a1[0]) * b1[0], silu_f(a1[1]) * b1[1]); w.w = cvt_pk_bf16(silu_f(a1[2]) * b1[2], silu_f(a1[3]) * b1[3]);
                    *(u32x4*)rowp = w;
                    asm volatile("" ::: "memory");
                }
        } else if (mode == 1) {
            const int col0 = u.pn * 256 + wc * 32 + 8 * fq, b = u.pm >> 3;
#pragma unroll
            for (int bj = 0; bj < 2; ++bj) {
                const f32x4 g0 = *(const f32x4*)(gate + (size_t)b * NMOD + col0 + bj * 128) * coef, g1 = *(const f32x4*)(gate + (size_t)b * NMOD + col0 + bj * 128 + 4) * coef;
#pragma unroll
                for (int ai = 0; ai < 2; ++ai)
#pragma unroll
                    for (int m = 0; m < 4; ++m) {
                        const size_t off = (size_t)(row0 + ai * 128 + m * 16) * DM + col0 + bj * 128;
                        const f32x4 bs0 = *(const f32x4*)(base + off), bs1 = *(const f32x4*)(base + off + 4);
                        *(f32x4*)(out + off) = bs0 + g0 * acc[ai][bj][m][0];
                        *(f32x4*)(out + off + 4) = bs1 + g1 * acc[ai][bj][m][1];
                        if (m & 1) asm volatile("" ::: "memory");
                    }
            }
        } else {
            const int col0 = u.pn * 256 + wc * 32 + 8 * fq;
#pragma unroll
            for (int ai = 0; ai < 2; ++ai)
#pragma unroll
                for (int m = 0; m < 4; ++m) {
                    bf16_t* rowp = O + (size_t)(row0 + ai * 128 + m * 16) * ldc + col0;
#pragma unroll
                    for (int bj = 0; bj < 2; ++bj) {
                        const f32x4 v0 = acc[ai][bj][m][0], v1 = acc[ai][bj][m][1];
                        u32x4 w; w.x = cvt_pk_bf16(v0[0], v0[1]); w.y = cvt_pk_bf16(v0[2], v0[3]); w.z = cvt_pk_bf16(v1[0], v1[1]); w.w = cvt_pk_bf16(v1[2], v1[3]);
                        *(u32x4*)(rowp + bj * 128) = w;
                    }
                }
        }
    }
};

__device__ __forceinline__ void tr_item(const float* __restrict__ W, int K, int N, bf16_t* __restrict__ WT, int dst_n0, int src_n0, int k0, LAS float* scr, int lane) {
#pragma unroll 8
    for (int i = 0; i < 32; ++i) { const int kk = 2 * i + (lane >> 5); scr[kk * 33 + (lane & 31)] = W[(size_t)(k0 + kk) * N + src_n0 + (lane & 31)]; }
    asm volatile("s_waitcnt lgkmcnt(0)" ::: "memory");
    const int c = lane & 7;
#pragma unroll
    for (int j = 0; j < 4; ++j) {
        const int n = (lane >> 3) + 8 * j; const LAS float* s = scr + (8 * c) * 33 + n;
        u32x4 o; o.x = cvt_pk_bf16(s[0 * 33], s[1 * 33]); o.y = cvt_pk_bf16(s[2 * 33], s[3 * 33]); o.z = cvt_pk_bf16(s[4 * 33], s[5 * 33]); o.w = cvt_pk_bf16(s[6 * 33], s[7 * 33]);
        *(u32x4*)(WT + (size_t)(dst_n0 + n) * K + k0 + 8 * c) = o;
    }
    asm volatile("s_waitcnt lgkmcnt(0)" ::: "memory");
}

__device__ __forceinline__ void prep_phase(const Params& p, LAS unsigned char* lds, int tid, int bx, int gdim) {
    const int lane = tid & 63, wave = tid >> 6;
    const int gw = bx * 8 + wave, ngw = gdim * 8;
    unsigned char* ws = p.ws;
    {
        LAS float* scr = (LAS float*)(lds + wave * 16384);
        constexpr int I_UP = 8 * 16 * 176, I_DN = 8 * 44 * 32, I_EI = 2 * 16 * 72, I_EO = 2 * 16 * 32, I_OI = 2 * 16 * 160, I_OO = 2 * 16 * 32;
        constexpr int NITEMS = I_UP + I_DN + I_EI + I_EO + I_OI + I_OO;
        for (int it = gw; it < NITEMS; it += ngw) {
            int r = it;
            if (r < I_UP) { const int mat = r / 2816, q = r % 2816, kb = q / 176, nb = q % 176, dn0 = nb * 32; const int src = ((dn0 >> 7) & 1) * FF + (dn0 >> 8) * 128 + (dn0 & 127);
                tr_item(p.ffn_up + (size_t)mat * DM * NUP, DM, NUP, (bf16_t*)(ws + WS_WUP) + (size_t)mat * NUP * DM, dn0, src, kb * 64, scr, lane); continue; }
            r -= I_UP;
            if (r < I_DN) { const int mat = r / 1408, q = r % 1408, kb = q / 32, nb = q % 32;
                tr_item(p.ffn_down + (size_t)mat * FF * DM, FF, DM, (bf16_t*)(ws + WS_WDN) + (size_t)mat * DM * FF, nb * 32, nb * 32, kb * 64, scr, lane); continue; }
            r -= I_DN;
            if (r < I_EI) { const int mat = r / 1152, q = r % 1152, kb = q / 72, nb = q % 72;
                tr_item(p.even_w_in + (size_t)mat * DM * EIN, DM, EIN, (bf16_t*)(ws + WS_WEIN) + (size_t)mat * EIN * DM, nb * 32, nb * 32, kb * 64, scr, lane); continue; }
            r -= I_EI;
            if (r < I_EO) { const int mat = r / 512, q = r % 512, kb = q / 32, nb = q % 32;
                tr_item(p.even_w_out + (size_t)mat * DM * DM, DM, DM, (bf16_t*)(ws + WS_WEOUT) + (size_t)mat * DM * DM, nb * 32, nb * 32, kb * 64, scr, lane); continue; }
            r -= I_EO;
            if (r < I_OI) { const int mat = r / 2560, q = r % 2560, kb = q / 160, nb = q % 160;
                tr_item(p.odd_w_in + (size_t)mat * DM * OIN, DM, OIN, (bf16_t*)(ws + WS_WOIN) + (size_t)mat * OIN * DM, nb * 32, nb * 32, kb * 64, scr, lane); continue; }
            r -= I_OI;
            { const int mat = r / 512, q = r % 512, kb = q / 32, nb = q % 32;
                tr_item(p.odd_w_out + (size_t)mat * DM * DM, DM, DM, (bf16_t*)(ws + WS_WOOUT) + (size_t)mat * DM * DM, nb * 32, nb * 32, kb * 64, scr, lane); }
        }
    }
    __syncthreads();
    {
        LAS float* sc = (LAS float*)lds;
        LAS float* red = (LAS float*)(lds + 65536);
        float* mod = (float*)(ws + WS_MOD);
        for (int i = tid; i < 16 * 1024; i += 512) { const int b = i >> 10, k = i & 1023; sc[k * 16 + b] = silu_f(p.c[i]); }
        __syncthreads();
        const int cl = tid & 127, kq = tid >> 7;
        for (int unit = bx; unit < 288; unit += gdim) {
            const int l = unit / 72, n0 = (unit % 72) * 128;
            const float* w = p.ada_w + (size_t)l * DM * NMOD + n0 + cl;
            float acc[16];
#pragma unroll
            for (int b = 0; b < 16; ++b) acc[b] = 0.f;
#pragma unroll 4
            for (int k = kq * 256; k < kq * 256 + 256; ++k) {
                const float wv = w[(size_t)k * NMOD];
                const LAS f32x4* s4 = (const LAS f32x4*)(sc + k * 16);
                const f32x4 s0 = s4[0], s1 = s4[1], s2 = s4[2], s3 = s4[3];
                acc[0] += s0[0] * wv; acc[1] += s0[1] * wv; acc[2] += s0[2] * wv; acc[3] += s0[3] * wv;
                acc[4] += s1[0] * wv; acc[5] += s1[1] * wv; acc[6] += s1[2] * wv; acc[7] += s1[3] * wv;
                acc[8] += s2[0] * wv; acc[9] += s2[1] * wv; acc[10] += s2[2] * wv; acc[11] += s2[3] * wv;
                acc[12] += s3[0] * wv; acc[13] += s3[1] * wv; acc[14] += s3[2] * wv; acc[15] += s3[3] * wv;
            }
#pragma unroll
            for (int b = 0; b < 16; ++b) red[(kq * 16 + b) * 128 + cl] = acc[b];
            __syncthreads();
            for (int o = tid; o < 2048; o += 512) {
                const int b = o >> 7, cc = o & 127;
                const float v = red[(0 * 16 + b) * 128 + cc] + red[(1 * 16 + b) * 128 + cc] + red[(2 * 16 + b) * 128 + cc] + red[(3 * 16 + b) * 128 + cc] + p.ada_b[(size_t)l * NMOD + n0 + cc];
                mod[((size_t)l * 16 + b) * NMOD + n0 + cc] = v;
            }
            __syncthreads();
        }
    }
}

__device__ __forceinline__ void norm_phase(const float* __restrict__ xin, const float* __restrict__ g, const float* __restrict__ modl, int shift_idx, bf16_t* __restrict__ h, int tid, int bx, int gdim) {
    const int lane = tid & 63, wave = tid >> 6;
    const int gw = bx * 8 + wave, ngw = gdim * 8;
    const int rpw = (M_TOK + ngw - 1) / ngw;
    int r0 = gw * rpw, r1 = r0 + rpw; if (r1 > M_TOK) r1 = M_TOK;
    f32x4 A[4], Bc[4]; int bcur = -1;
    for (int r = r0; r < r1; ++r) {
        const int b = r / SEQ;
        if (b != bcur) {
            bcur = b;
#pragma unroll
            for (int j = 0; j < 4; ++j) {
                const int col = 4 * lane + 256 * j;
                const f32x4 gv = *(const f32x4*)(g + col), sc = *(const f32x4*)(modl + (size_t)b * NMOD + (shift_idx + 1) * 1024 + col), sh = *(const f32x4*)(modl + (size_t)b * NMOD + shift_idx * 1024 + col);
                A[j] = gv * (sc + 1.0f); Bc[j] = sh;
            }
        }
        const f32x4* xr = (const f32x4*)(xin + (size_t)r * DM) + lane;
        f32x4 v[4]; float ss = 0.f;
#pragma unroll
        for (int j = 0; j < 4; ++j) { v[j] = xr[64 * j]; ss += (v[j][0] * v[j][0] + v[j][1] * v[j][1]) + (v[j][2] * v[j][2] + v[j][3] * v[j][3]); }
        ss = wave_sum(ss);
        const float rstd = 1.0f / sqrtf(ss * (1.0f / DM) + EPS);
        u32x2* o8 = (u32x2*)(h + (size_t)r * DM) + lane;
#pragma unroll
        for (int j = 0; j < 4; ++j) { const f32x4 y = v[j] * rstd * A[j] + Bc[j]; u32x2 w; w.x = cvt_pk_bf16(y[0], y[1]); w.y = cvt_pk_bf16(y[2], y[3]); o8[64 * j] = w; }
    }
}

__device__ __forceinline__ void qknorm_phase(bf16_t* qkv, const float* __restrict__ qkg, int tid, int bx, int gdim) {
    const int lane = tid & 63, wave = tid >> 6;
    const int gw = bx * 8 + wave, ngw = gdim * 8;
    const int sub = lane >> 3, c8 = (lane & 7) * 8;
    for (int m = gw; m < M_TOK; m += ngw) {
        bf16_t* row = qkv + (size_t)m * EIN;
#pragma unroll
        for (int rd = 0; rd < 4; ++rd) {
            const int vi = rd * 8 + sub; const bool act = vi < 26;
            int col, gs; float qs = 1.0f;
            if (vi < 8) { col = vi * 64; gs = 0; qs = 0.125f * LOG2E; }
            else if (vi < 16) { col = 512 + (vi - 8) * 64; gs = 1; }
            else if (vi < 24) { col = 1536 + (vi - 16) * 64; gs = 2; qs = 0.125f * LOG2E; }
            else { col = 2048 + ((vi - 24) & 1) * 64; gs = 3; }
            u32x4 raw = (u32x4){0u, 0u, 0u, 0u};
            if (act) raw = *(const u32x4*)(row + col + c8);
            float f[8] = {bf_lo(raw.x), bf_hi(raw.x), bf_lo(raw.y), bf_hi(raw.y), bf_lo(raw.z), bf_hi(raw.z), bf_lo(raw.w), bf_hi(raw.w)};
            float ss = 0.f;
#pragma unroll
            for (int e = 0; e < 8; ++e) ss += f[e] * f[e];
            ss += __shfl_xor(ss, 1); ss += __shfl_xor(ss, 2); ss += __shfl_xor(ss, 4);
            const float rstd = qs / sqrtf(ss * (1.0f / 64.0f) + EPS);
            const f32x4 g0 = *(const f32x4*)(qkg + gs * 64 + c8), g1 = *(const f32x4*)(qkg + gs * 64 + c8 + 4);
            u32x4 w;
            w.x = cvt_pk_bf16(f[0] * rstd * g0[0], f[1] * rstd * g0[1]); w.y = cvt_pk_bf16(f[2] * rstd * g0[2], f[3] * rstd * g0[3]);
            w.z = cvt_pk_bf16(f[4] * rstd * g1[0], f[5] * rstd * g1[1]); w.w = cvt_pk_bf16(f[6] * rstd * g1[2], f[7] * rstd * g1[3]);
            if (act) *(u32x4*)(row + col + c8) = w;
        }
    }
}

constexpr int A_K_OFF = 0, A_V_OFF = 8192, A_LUT_OFF = 8192 + 16384, A_Q_OFF = A_LUT_OFF + 2048;
__device__ __forceinline__ int t5_bucket(int rel) {
    const int n = rel < 0 ? -rel : rel; int b = rel > 0 ? 16 : 0;
    if (n < 8) b += n; else { const int v = 2 + (31 - __builtin_clz((unsigned)(n * n))); b += v < 15 ? v : 15; }
    return b;
}
__device__ __forceinline__ s16x4 tr16(const LAS unsigned char* p) {
    typedef short v4i16_t __attribute__((ext_vector_type(4)));
    return __builtin_bit_cast(s16x4, __builtin_amdgcn_ds_read_tr16_b64_v4i16((LAS v4i16_t*)p));
}
__device__ __forceinline__ int crow(int r, int hi) { return (r & 3) + 8 * (r >> 2) + 4 * hi; }

template <int DV, bool WIN>
__device__ __forceinline__ void attn_stream(LAS unsigned char* lds, const bf16_t* __restrict__ Kg, const bf16_t* __restrict__ Vg, const LAS unsigned char* qfp, int qw, int t0, int t1,
                                            float& m_run, float& l_run, f32x16 (&o)[DV / 32], int tid) {
    const int lane = tid & 63, r32 = lane & 31, hi = lane >> 5;
    const LAS float* lut = (const LAS float*)(lds + A_LUT_OFF);
    constexpr int VP = DV / 64, CPK = DV / 8;
    const int kkey = tid >> 3, kch = tid & 7;
    const bf16_t* kp = Kg + (size_t)kkey * EIN + kch * 8;
    const unsigned kdst = A_K_OFF + kch * 1024 + kkey * 16;
    u32x4 kreg, vreg[VP];
    kreg = *(const u32x4*)(kp + (size_t)t0 * 64 * EIN);
#pragma unroll
    for (int j = 0; j < VP; ++j) { const int pidx = tid + 512 * j, key = pidx / CPK, c = pidx % CPK; vreg[j] = *(const u32x4*)(Vg + (size_t)(t0 * 64 + key) * EIN + c * 8); }
    const LAS unsigned char* kb = lds + A_K_OFF + hi * 1024 + r32 * 16;
    const LAS unsigned char* vb = lds + A_V_OFF + ((lane >> 4) & 1) * 32 + (lane & 3) * 8 + (4 * hi + ((lane & 15) >> 2)) * 64;
    for (int t = t0; t < t1; ++t) {
        __syncthreads();
        *(LAS u32x4*)(lds + kdst) = kreg;
#pragma unroll
        for (int j = 0; j < VP; ++j) { const int pidx = tid + 512 * j, key = pidx / CPK, c = pidx % CPK; *(LAS u32x4*)(lds + A_V_OFF + (c >> 2) * 4096 + (key >> 4) * 1024 + (key & 15) * 64 + (c & 3) * 16) = vreg[j]; }
        __syncthreads();
        if (t + 1 < t1) {
            kreg = *(const u32x4*)(kp + (size_t)(t + 1) * 64 * EIN);
#pragma unroll
            for (int j = 0; j < VP; ++j) { const int pidx = tid + 512 * j, key = pidx / CPK, c = pidx % CPK; vreg[j] = *(const u32x4*)(Vg + (size_t)((t + 1) * 64 + key) * EIN + c * 8); }
        }
        const int k0 = t * 64, relmin = k0 - (qw + 31), relmax = k0 + 63 - qw;
        if (WIN && (relmin > 128 || relmax < -128)) continue;
        f32x16 p0, p1;
        if (!WIN && relmin >= 91) { const float cb = lut[224 + 128];
#pragma unroll
            for (int r = 0; r < 16; ++r) { p0[r] = cb; p1[r] = cb; } }
        else if (!WIN && relmax <= -91) { const float cb = lut[224 - 128];
#pragma unroll
            for (int r = 0; r < 16; ++r) { p0[r] = cb; p1[r] = cb; } }
        else { const LAS float* lp = lut + (k0 - qw - r32 + 4 * hi + 224);
#pragma unroll
            for (int r = 0; r < 16; ++r) { p0[r] = lp[(r & 3) + 8 * (r >> 2)]; p1[r] = lp[(r & 3) + 8 * (r >> 2) + 32]; } }
#pragma unroll
        for (int d0 = 0; d0 < 4; ++d0) {
            const bf16x8 b0 = *(const LAS bf16x8*)(kb + d0 * 2048), b1 = *(const LAS bf16x8*)(kb + d0 * 2048 + 512);
            const bf16x8 qv = *(const LAS bf16x8*)(qfp + d0 * 1024);
            p0 = __builtin_amdgcn_mfma_f32_32x32x16_bf16(b0, qv, p0, 0, 0, 0);
            p1 = __builtin_amdgcn_mfma_f32_32x32x16_bf16(b1, qv, p1, 0, 0, 0);
        }
        __builtin_amdgcn_sched_barrier(0);
        float mx = fmaxf(p0[0], p1[0]);
#pragma unroll
        for (int r = 1; r < 16; ++r) mx = fmaxf(mx, fmaxf(p0[r], p1[r]));
        mx = fmaxf(mx, __shfl_xor(mx, 32));
        const float mn = fmaxf(m_run, mx), alpha = ex2(m_run - mn); m_run = mn;
        float rs = 0.f;
#pragma unroll
        for (int r = 0; r < 16; ++r) { p0[r] = ex2(p0[r] - mn); p1[r] = ex2(p1[r] - mn); rs += p0[r] + p1[r]; }
        l_run = l_run * alpha + rs;
#pragma unroll
        for (int db = 0; db < DV / 32; ++db) o[db] *= alpha;
        u32x4 pw[4];
#pragma unroll
        for (int k = 0; k < 2; ++k) {
            pw[k] = (u32x4){cvt_pk_bf16(p0[8 * k + 0], p0[8 * k + 1]), cvt_pk_bf16(p0[8 * k + 2], p0[8 * k + 3]), cvt_pk_bf16(p0[8 * k + 4], p0[8 * k + 5]), cvt_pk_bf16(p0[8 * k + 6], p0[8 * k + 7])};
            pw[2 + k] = (u32x4){cvt_pk_bf16(p1[8 * k + 0], p1[8 * k + 1]), cvt_pk_bf16(p1[8 * k + 2], p1[8 * k + 3]), cvt_pk_bf16(p1[8 * k + 4], p1[8 * k + 5]), cvt_pk_bf16(p1[8 * k + 6], p1[8 * k + 7])};
        }
        __builtin_amdgcn_sched_barrier(0);
#pragma unroll
        for (int db = 0; db < DV / 32; ++db) {
#pragma unroll
            for (int ks = 0; ks < 4; ++ks) {
                const s16x4 lo = tr16(vb + db * 4096 + ks * 1024), hh = tr16(vb + db * 4096 + ks * 1024 + 512);
                const bf16x8 vf = (bf16x8){lo[0], lo[1], lo[2], lo[3], hh[0], hh[1], hh[2], hh[3]};
                o[db] = __builtin_amdgcn_mfma_f32_32x32x16_bf16(vf, __builtin_bit_cast(bf16x8, pw[ks]), o[db], 0, 0, 0);
            }
            __builtin_amdgcn_sched_barrier(0);
        }
    }
}

__device__ __forceinline__ void build_lut(LAS unsigned char* lds, const float* __restrict__ rel_bias, int head, bool win, int tid) {
    LAS float* lut = (LAS float*)(lds + A_LUT_OFF);
    __syncthreads();
    if (tid < 449) { const int rel = tid - 224; float v = rel_bias[t5_bucket(rel) * 12 + head] * LOG2E; if (win && (rel < -128 || rel > 128)) v = -INFINITY; lut[tid] = v; }
}

__device__ __forceinline__ void attn_phase(const Params& p, LAS unsigned char* lds, int layer, int tid, int bx0, int gdim) {
    const int lane = tid & 63, r32 = lane & 31, hi = lane >> 5, wid = tid >> 6;
    const int e = layer >> 1;
    const bf16_t* qkv = (const bf16_t*)(p.ws + WS_R1);
    bf16_t* yb = (bf16_t*)(p.ws + WS_Y);
    const int G = gdim, bx = bx0;
    const int vcu = (G % 8 == 0) ? (bx % 8) * (G / 8) + bx / 8 : bx;
    const float lam_init = 0.8f - 0.6f * expf(-0.3f * (float)layer);
    float lam;
    { const float* lp = p.diff_lambda + e * 256; const float s01 = wave_sum(lp[lane] * lp[64 + lane]), s23 = wave_sum(lp[128 + lane] * lp[192 + lane]); lam = expf(s01) - expf(s23) + lam_init; }
#ifndef NO_DIFF
    for (int unit = vcu; unit < 512; unit += G) {
        const int qb = unit & 7, h = (unit >> 3) & 3, b = unit >> 5;
        build_lut(lds, p.rel_bias, h, false, tid);
        const int qw = qb * 256 + wid * 32;
        const bf16_t* qkv_b = qkv + (size_t)b * SEQ * EIN;
        f32x4* stash = (f32x4*)(p.ws + WS_O1) + ((size_t)(bx * 8 + wid) * 16) * 64 + lane;
#pragma unroll 1
        for (int s = 0; s < 2; ++s) {
            LAS unsigned char* qfp = lds + A_Q_OFF + wid * 4096 + hi * 512 + r32 * 16;
#pragma unroll
            for (int d0 = 0; d0 < 4; ++d0) *(LAS bf16x8*)(qfp + d0 * 1024) = *(const bf16x8*)(qkv_b + (size_t)(qw + r32) * EIN + h * 128 + s * 64 + d0 * 16 + hi * 8);
            f32x16 o[4];
#pragma unroll
            for (int db = 0; db < 4; ++db)
#pragma unroll
                for (int r = 0; r < 16; ++r) o[db][r] = 0.f;
            float m_run = -1e30f, l_run = 0.f;
            attn_stream<128, false>(lds, qkv_b + 512 + h * 128 + s * 64, qkv_b + 1024 + h * 128, qfp, qw, 0, SEQ / 64, m_run, l_run, o, tid);
            const float lt = l_run + __shfl_xor(l_run, 32), inv = 1.0f / lt;
            if (s == 0) {
#pragma unroll
                for (int db = 0; db < 4; ++db)
#pragma unroll
                    for (int g4 = 0; g4 < 4; ++g4) stash[(db * 4 + g4) * 64] = (f32x4){o[db][4 * g4 + 0] * inv, o[db][4 * g4 + 1] * inv, o[db][4 * g4 + 2] * inv, o[db][4 * g4 + 3] * inv};
            } else {
                const float li = lam * inv; float ss = 0.f;
#pragma unroll
                for (int db = 0; db < 4; ++db)
#pragma unroll
                    for (int g4 = 0; g4 < 4; ++g4) { const f32x4 a = stash[(db * 4 + g4) * 64];
#pragma unroll
                        for (int e2 = 0; e2 < 4; ++e2) { const float v = a[e2] - o[db][4 * g4 + e2] * li; o[db][4 * g4 + e2] = v; ss += v * v; } }
                ss += __shfl_xor(ss, 32);
                const float rstd = (1.0f - lam_init) / sqrtf(ss * (1.0f / 128.0f) + EPS);
                const float* sg = p.diff_subln_g + e * 128;
                bf16_t* yrow = yb + (size_t)(b * SEQ + qw + r32) * DM + h * 128;
#pragma unroll
                for (int db = 0; db < 4; ++db)
#pragma unroll
                    for (int g4 = 0; g4 < 4; ++g4) {
                        const int dv = 32 * db + 8 * g4 + 4 * hi; const f32x4 gv = *(const f32x4*)(sg + dv);
                        u32x2 w; w.x = cvt_pk_bf16(o[db][4 * g4 + 0] * rstd * gv[0], o[db][4 * g4 + 1] * rstd * gv[1]); w.y = cvt_pk_bf16(o[db][4 * g4 + 2] * rstd * gv[2], o[db][4 * g4 + 3] * rstd * gv[3]);
                        *(u32x2*)(yrow + dv) = w;
                    }
            }
        }
    }
#endif
}
__device__ __forceinline__ void attn_win_phase(const Params& p, LAS unsigned char* lds, int layer, int tid, int bx0, int gdim) {
    const int lane = tid & 63, r32 = lane & 31, hi = lane >> 5, wid = tid >> 6;
    const int e = layer >> 1;
    const bf16_t* qkv = (const bf16_t*)(p.ws + WS_R1);
    bf16_t* yb = (bf16_t*)(p.ws + WS_Y);
    const int G = gdim, bx = bx0;
    const int vcu = (G % 8 == 0) ? (bx % 8) * (G / 8) + bx / 8 : bx;
#ifndef NO_WIN
    for (int unit = vcu; unit < 1024; unit += G) {
        const int qb = unit & 7, hq = (unit >> 3) & 7, b = unit >> 6, kvh = hq >> 2;
        build_lut(lds, p.rel_bias, 4 + hq, true, tid);
        const int qw = qb * 256 + wid * 32;
        const bf16_t* qkv_b = qkv + (size_t)b * SEQ * EIN;
        LAS unsigned char* qfp = lds + A_Q_OFF + wid * 4096 + hi * 512 + r32 * 16;
#pragma unroll
        for (int d0 = 0; d0 < 4; ++d0) *(LAS bf16x8*)(qfp + d0 * 1024) = *(const bf16x8*)(qkv_b + (size_t)(qw + r32) * EIN + 1536 + hq * 64 + d0 * 16 + hi * 8);
        f32x16 o[2];
#pragma unroll
        for (int db = 0; db < 2; ++db)
#pragma unroll
            for (int r = 0; r < 16; ++r) o[db][r] = 0.f;
        float m_run = p.sink_logit[e * 8 + hq] * LOG2E, l_run = 0.5f;
        int t0 = (qb * 256 - 128) / 64, t1 = (qb * 256 + 384) / 64; if (qb == 0) t0 = 0; if (t1 > SEQ / 64) t1 = SEQ / 64;
        attn_stream<64, true>(lds, qkv_b + 2048 + kvh * 64, qkv_b + 2176 + kvh * 64, qfp, qw, t0, t1, m_run, l_run, o, tid);
        const float lt = l_run + __shfl_xor(l_run, 32), inv = 1.0f / lt;
        bf16_t* yrow = yb + (size_t)(b * SEQ + qw + r32) * DM + 512 + hq * 64;
#pragma unroll
        for (int db = 0; db < 2; ++db)
#pragma unroll
            for (int g4 = 0; g4 < 4; ++g4) {
                const int dv = 32 * db + 8 * g4 + 4 * hi;
                u32x2 w; w.x = cvt_pk_bf16(o[db][4 * g4 + 0] * inv, o[db][4 * g4 + 1] * inv); w.y = cvt_pk_bf16(o[db][4 * g4 + 2] * inv, o[db][4 * g4 + 3] * inv);
                *(u32x2*)(yrow + dv) = w;
            }
    }
#endif
}

constexpr int HC = 16;
constexpr int H_F = 0, H_K = 8192, H_QF = 16384, H_V = 24576, H_C = 32768, H_OP = 33024, H_LB = H_OP + HC * 8 * 128 * 4;
__device__ __forceinline__ void hgrn_phase(const Params& p, LAS unsigned char* lds, int layer, int tid, int bx, int gdim) {
    const int lane = tid & 63, wid = tid >> 6;
    bf16_t* qkv = (bf16_t*)(p.ws + WS_R1);
    LAS float* Fs = (LAS float*)(lds + H_F); LAS float* Ks = (LAS float*)(lds + H_K); LAS float* QFs = (LAS float*)(lds + H_QF); LAS float* Vs = (LAS float*)(lds + H_V);
    LAS float* Cs = (LAS float*)(lds + H_C); LAS float* OP = (LAS float*)(lds + H_OP); LAS float* LB = (LAS float*)(lds + H_LB);
    for (int unit = bx; unit < 256; unit += gdim) {
        const int b = unit >> 4, h = (unit >> 1) & 7, dir = unit & 1;
        __syncthreads();
        if (tid < 128) {
            const float* cl = p.c_lower_bound + (size_t)dir * 4 * 1024 + h * 128 + tid;
            const float v0 = cl[0], v1 = cl[1024], v2 = cl[2048], v3 = cl[3072];
            const float mx = fmaxf(fmaxf(v0, v1), fmaxf(v2, v3));
            const float e0 = expf(v0 - mx), e1 = expf(v1 - mx), e2 = expf(v2 - mx), e3 = expf(v3 - mx), inv = 1.0f / (e0 + e1 + e2 + e3);
            float lb = 0.f; if (layer >= 1) lb += e1; if (layer >= 2) lb += e2; if (layer >= 3) lb += e3;
            LB[tid] = lb * inv;
        }
        __syncthreads();
        const int li = tid >> 5, ch0 = (tid & 31) * 4;
        const f32x4 lb4 = *(const LAS f32x4*)(LB + ch0);
        bf16_t* base = qkv + (size_t)b * SEQ * OIN + h * 128 + ch0;
        const int fcol = 1024 + dir * 1024;
        f32x2 S[16];
#pragma unroll
        for (int j = 0; j < 16; ++j) S[j] = (f32x2){0.f, 0.f};
        u32x2 rq, rf, rv;
        { const int t = dir ? (SEQ - 1 - li) : li; const bf16_t* row = base + (size_t)t * OIN; rq = *(const u32x2*)row; rf = *(const u32x2*)(row + fcol); rv = *(const u32x2*)(row + 3072); }
        for (int c = 0; c < SEQ / HC; ++c) {
            {
                const float q[4] = {bf_lo(rq.x), bf_hi(rq.x), bf_lo(rq.y), bf_hi(rq.y)}, f[4] = {bf_lo(rf.x), bf_hi(rf.x), bf_lo(rf.y), bf_hi(rf.y)};
                const f32x4 v4 = (f32x4){bf_lo(rv.x), bf_hi(rv.x), bf_lo(rv.y), bf_hi(rv.y)};
                f32x4 fg, kk, qf; float cp = 0.f;
#pragma unroll
                for (int e = 0; e < 4; ++e) {
                    const float qs = silu_f(q[e]), sg = sigm_f(f[e]), sn = sigm_f(-f[e]);
                    fg[e] = lb4[e] + (1.0f - lb4[e]) * sg; kk[e] = (1.0f - lb4[e]) * sn; qf[e] = qs * fg[e]; cp += qs * kk[e];
                }
                cp += __shfl_xor(cp, 1); cp += __shfl_xor(cp, 2); cp += __shfl_xor(cp, 4); cp += __shfl_xor(cp, 8); cp += __shfl_xor(cp, 16);
                *(LAS f32x4*)(Fs + li * 128 + ch0) = fg; *(LAS f32x4*)(Ks + li * 128 + ch0) = kk; *(LAS f32x4*)(QFs + li * 128 + ch0) = qf; *(LAS f32x4*)(Vs + li * 128 + ch0) = v4;
                if ((tid & 31) == 0) Cs[li] = cp;
            }
            __syncthreads();
            if (c + 1 < SEQ / HC) { const int tt = (c + 1) * HC + li, t = dir ? (SEQ - 1 - tt) : tt; const bf16_t* row = base + (size_t)t * OIN; rq = *(const u32x2*)row; rf = *(const u32x2*)(row + fcol); rv = *(const u32x2*)(row + 3072); }
#pragma unroll 2
            for (int i = 0; i < HC; ++i) {
                const f32x2 v2 = *(const LAS f32x2*)(Vs + i * 128 + 2 * lane);
                const float cc = Cs[i];
                f32x2 oacc = (wid == 0) ? v2 * cc : (f32x2){0.f, 0.f};
#pragma unroll
                for (int j4 = 0; j4 < 4; ++j4) {
                    const f32x4 f4 = *(const LAS f32x4*)(Fs + i * 128 + 16 * wid + 4 * j4), k4 = *(const LAS f32x4*)(Ks + i * 128 + 16 * wid + 4 * j4), q4 = *(const LAS f32x4*)(QFs + i * 128 + 16 * wid + 4 * j4);
#pragma unroll
                    for (int e = 0; e < 4; ++e) { oacc += S[4 * j4 + e] * q4[e]; S[4 * j4 + e] = S[4 * j4 + e] * f4[e] + v2 * k4[e]; }
                }
                *(LAS f32x2*)(OP + (i * 8 + wid) * 128 + 2 * lane) = oacc;
            }
            __syncthreads();
            {
                f32x4 s = *(const LAS f32x4*)(OP + (li * 8 + 0) * 128 + ch0);
#pragma unroll
                for (int w = 1; w < 8; ++w) s += *(const LAS f32x4*)(OP + (li * 8 + w) * 128 + ch0);
                const int tt = c * HC + li, t = dir ? (SEQ - 1 - tt) : tt;
                u32x2 w2; w2.x = cvt_pk_bf16(s[0], s[1]); w2.y = cvt_pk_bf16(s[2], s[3]);
                *(u32x2*)(base + (size_t)t * OIN + fcol) = w2;
            }
        }
    }
}
__device__ __forceinline__ void hgrn_combine_phase(const Params& p, int layer, int tid, int bx, int gdim) {
    const int lane = tid & 63, wave = tid >> 6;
    const int gw = bx * 8 + wave, ngw = gdim * 8;
    const bf16_t* qkv = (const bf16_t*)(p.ws + WS_R1);
    bf16_t* yb = (bf16_t*)(p.ws + WS_Y);
    const float* og = p.c_out_norm_g + (layer >> 1) * 128;
    for (int m = gw; m < M_TOK; m += ngw) {
        const bf16_t* row = qkv + (size_t)m * OIN;
#pragma unroll
        for (int j = 0; j < 2; ++j) {
            const int ch = j * 512 + lane * 8;
            const u32x4 a = *(const u32x4*)(row + 1024 + ch), bb = *(const u32x4*)(row + 2048 + ch), gg = *(const u32x4*)(row + 4096 + ch);
            float o[8] = {bf_lo(a.x) + bf_lo(bb.x), bf_hi(a.x) + bf_hi(bb.x), bf_lo(a.y) + bf_lo(bb.y), bf_hi(a.y) + bf_hi(bb.y), bf_lo(a.z) + bf_lo(bb.z), bf_hi(a.z) + bf_hi(bb.z), bf_lo(a.w) + bf_lo(bb.w), bf_hi(a.w) + bf_hi(bb.w)};
            const float g[8] = {bf_lo(gg.x), bf_hi(gg.x), bf_lo(gg.y), bf_hi(gg.y), bf_lo(gg.z), bf_hi(gg.z), bf_lo(gg.w), bf_hi(gg.w)};
            float ss = 0.f;
#pragma unroll
            for (int e = 0; e < 8; ++e) ss += o[e] * o[e];
            ss += __shfl_xor(ss, 1); ss += __shfl_xor(ss, 2); ss += __shfl_xor(ss, 4); ss += __shfl_xor(ss, 8);
            const float rstd = 1.0f / sqrtf(ss * (1.0f / 128.0f) + EPS);
            const f32x4 g0 = *(const f32x4*)(og + (ch & 127)), g1 = *(const f32x4*)(og + (ch & 127) + 4);
            u32x4 w;
            w.x = cvt_pk_bf16(o[0] * rstd * g0[0] * silu_f(g[0]), o[1] * rstd * g0[1] * silu_f(g[1])); w.y = cvt_pk_bf16(o[2] * rstd * g0[2] * silu_f(g[2]), o[3] * rstd * g0[3] * silu_f(g[3]));
            w.z = cvt_pk_bf16(o[4] * rstd * g1[0] * silu_f(g[4]), o[5] * rstd * g1[1] * silu_f(g[5])); w.w = cvt_pk_bf16(o[6] * rstd * g1[2] * silu_f(g[6]), o[7] * rstd * g1[3] * silu_f(g[7]));
            *(u32x4*)(yb + (size_t)m * DM + ch) = w;
        }
    }
}

__global__ void __launch_bounds__(512) mega_fwd(Params p) {
    extern __shared__ __attribute__((aligned(16))) unsigned char lds_raw[];
    LAS unsigned char* lds = (LAS unsigned char*)lds_raw;
    cg::grid_group grid = cg::this_grid();
#define HB ((bf16_t*)(p.ws + WS_H))
#define YB ((bf16_t*)(p.ws + WS_Y))
#define R1 ((bf16_t*)(p.ws + WS_R1))
#pragma unroll 1
    for (int ph = p.ph_lo; ph < p.ph_hi; ++ph) {
        if (ph > p.ph_lo) grid.sync();
        int tid = threadIdx.x, bx = blockIdx.x; asm volatile("" : "+v"(tid)); asm volatile("" : "+s"(bx)); int gdim = gridDim.x; asm volatile("" : "+s"(gdim));
        typedef const __attribute__((address_space(4))) Params* kparg_t;
        kparg_t kq = (kparg_t)__builtin_amdgcn_kernarg_segment_ptr(); asm volatile("" : "+s"(kq));
        Params P;
#if defined(__HIP_DEVICE_COMPILE__)
        P = *kq;
#else
        P = p;
#endif
        if (ph == 0) {
#ifndef NO_PREP
            prep_phase(P, lds, tid, bx, gdim);
#endif
            continue; }
        const int l = (ph - 1) / 11, s = (ph - 1) % 11;
        const float* modl = (const float*)(P.ws + WS_MOD) + (size_t)l * 16 * NMOD;
        if (s == 0 || s == 3 || s == 8) {
            const int j = (s == 0) ? 0 : (s == 3 ? 1 : 2);
            const float* xin = (l == 0 && s == 0) ? P.x : P.out;
            norm_phase(xin, P.norm_g + (size_t)(l * 3 + j) * DM, modl, 3 * j, HB, tid, bx, gdim);
        } else if (s == 1 || s == 9 || s == 2 || s == 10 || s == 7 || s == 4) {
            pg8::Gemm g; EpiMulti E; E.O = R1; E.ldc = FF; E.base = P.out; E.out = P.out; E.gate = modl; E.coef = 1.0f;
            if (s == 1 || s == 9) {
                const int fi = (s == 1) ? 0 : 1;
                g = pg8::Gemm{HB, (const bf16_t*)(P.ws + WS_WUP) + (size_t)(l * 2 + fi) * NUP * DM, M_TOK, NUP, DM}; E.mode = 0;
            } else if (s == 7) {
                const bf16_t* w = (l & 1) ? (const bf16_t*)(P.ws + WS_WOOUT) + (size_t)(l >> 1) * DM * DM : (const bf16_t*)(P.ws + WS_WEOUT) + (size_t)(l >> 1) * DM * DM;
                g = pg8::Gemm{YB, w, M_TOK, DM, DM}; E.mode = 1; E.gate = modl + 5 * 1024; E.coef = 1.0f;
            } else if (s == 4) {
                const int N = (l & 1) ? OIN : EIN;
                const bf16_t* w = (l & 1) ? (const bf16_t*)(P.ws + WS_WOIN) + (size_t)(l >> 1) * OIN * DM : (const bf16_t*)(P.ws + WS_WEIN) + (size_t)(l >> 1) * EIN * DM;
                g = pg8::Gemm{HB, w, M_TOK, N, DM}; E.mode = 2; E.ldc = N;
            } else {
                const int fi = (s == 2) ? 0 : 1;
                g = pg8::Gemm{R1, (const bf16_t*)(P.ws + WS_WDN) + (size_t)(l * 2 + fi) * DM * FF, M_TOK, DM, FF}; E.mode = 1; E.gate = modl + (fi ? 8 : 2) * 1024; E.coef = 0.5f;
                if (l == 0 && s == 2) E.base = P.x;
            }
            pg8::StaticOrder S; S.init(g.M, g.N, gdim, bx);
#ifndef NO_G1
            pg8::gemm_phase<EpiMulti, pg8::StaticOrder, false>(lds, g, S, E, nullptr, tid);
#endif
        } else if (s == 5) {
            if (l & 1) {
#ifndef NO_HGRN
                hgrn_phase(P, lds, l, tid, bx, gdim);
#endif
            } else {
#ifndef NO_QKN
                qknorm_phase(R1, P.qk_norm_g + (size_t)(l >> 1) * 256, tid, bx, gdim);
#endif
            }
        } else {
            if (l & 1) {
#ifndef NO_COMB
                hgrn_combine_phase(P, l, tid, bx, gdim);
#endif
            } else {
#ifndef NO_ATTN
                attn_phase(P, lds, l, tid, bx, gdim);
                { int tid2 = tid; asm volatile("" : "+v"(tid2)); attn_win_phase(P, lds, l, tid2, bx, gdim); }
#endif
            }
        }
    }
#undef HB
#undef YB
#undef R1
}

#ifndef MK_PER_PHASE
#define MK_PER_PHASE 0
#endif
extern "C" void kernel_launch(void* const* d_in, const int* in_sizes, int n_in, void* d_out, int out_size, void* d_ws, size_t ws_size, hipStream_t stream) {
    static int grid = 0;
    if (grid == 0) {
        if (n_in != 18 || out_size != M_TOK * DM || ws_size < WS_END) { fprintf(stderr, "kernel_launch: unexpected shapes (n_in %d out %d ws %zu need %zu)\n", n_in, out_size, ws_size, (size_t)WS_END); grid = -1; return; }
        int dev = 0, cus = 0, per_cu = 0;
        hipGetDevice(&dev);
        hipDeviceGetAttribute(&cus, hipDeviceAttributeMultiprocessorCount, dev);
        if (hipFuncSetAttribute((const void*)mega_fwd, hipFuncAttributeMaxDynamicSharedMemorySize, LDS_BYTES) != hipSuccess) { fprintf(stderr, "kernel_launch: hipFuncSetAttribute failed\n"); grid = -1; return; }
        if (hipOccupancyMaxActiveBlocksPerMultiprocessor(&per_cu, (const void*)mega_fwd, 512, LDS_BYTES) != hipSuccess || per_cu < 1) { fprintf(stderr, "kernel_launch: occupancy query says %d\n", per_cu); per_cu = 1; }
        (void)hipGetLastError();
        grid = cus * 1;
    }
    if (grid < 0) return;
    Params p{};
    const float** pp = (const float**)&p;
    for (int i = 0; i < 18; ++i) pp[i] = (const float*)d_in[i];
    p.out = (float*)d_out; p.ws = (unsigned char*)d_ws;
#if MK_PER_PHASE
    for (int ph = 0; ph < N_PHASES; ++ph) {
        p.ph_lo = ph; p.ph_hi = ph + 1;
        hipLaunchKernelGGL(mega_fwd, dim3(grid), dim3(512), LDS_BYTES, stream, p);
    }
#else
    p.ph_lo = 0; p.ph_hi = N_PHASES;
    void* args[] = {&p};
    hipError_t e = hipLaunchCooperativeKernel((const void*)mega_fwd, dim3(grid), dim3(512), args, LDS_BYTES, stream);
    if (e != hipSuccess) fprintf(stderr, "cooperative launch failed: %s (grid %d)\n", hipGetErrorString(e), grid);
#endif
}
```

```cpp
#include <hip/hip_runtime.h>
#include <hip/hip_cooperative_groups.h>
#include <cstdio>
namespace cg = cooperative_groups;
namespace pg8 {
#define PG8_LAS __attribute__((address_space(3)))
typedef unsigned short bf16_t;
typedef short bf16x8 __attribute__((ext_vector_type(8)));
typedef float f32x4 __attribute__((ext_vector_type(4)));
typedef unsigned u32x4 __attribute__((ext_vector_type(4)));
constexpr int BM = 256, BK = 64, HALF = 128, HTB = HALF * BK * 2  , STAGE_BYTES = 8 * HTB, NXCD = 8, WGM = 8;

__host__ __device__ __forceinline__ int lds_byte(int r, int c) { const int st = (r >> 4) * 2 + (c >> 5), rr = r & 15, cc = c & 31, ob = rr * 64 + cc * 2; return st * 1024 + (ob ^ (((ob >> 9) & 1) << 5)); }
__host__ __device__ __forceinline__ void stage_rc(int b, int& R, int& C) { const int st = b / 1024, sb = b % 1024, swz = sb ^ (((sb >> 9) & 1) << 5); R = (st >> 1) * 16 + swz / 64; C = (st & 1) * 32 + (swz % 64) / 2; }
__host__ __device__ __forceinline__ int perm32(int rho) { const int n = rho >> 4, i = rho & 15; return 8 * (i >> 2) + 4 * n + (i & 3); }

struct Unit { int pm, pn; };
struct Gemm { const bf16_t* A; const bf16_t* Bt; int M, N, K; };

struct StaticOrder {
    int nM, nN, nwg, G, c;
    __host__ __device__ void init(int M, int N, int G_, int c_) { nM = M / BM; nN = N / BM; nwg = nM * nN; G = G_; c = c_; }
    __host__ __device__ bool next(int i, Unit& u) const {
        const long L = (long)i * G + c; if (L >= nwg) return false;
        int wgid = (int)L; { const int q = nwg / NXCD, r = nwg % NXCD, xcd = wgid % NXCD, off = wgid / NXCD; wgid = (xcd < r ? xcd * (q + 1) : r * (q + 1) + (xcd - r) * q) + off; }
        const int nig = WGM * nN, gid = wgid / nig, fm = gid * WGM, gsz = (nM - fm) < WGM ? (nM - fm) : WGM;
        u.pm = fm + ((wgid % nig) % gsz); u.pn = (wgid % nig) / gsz; return true;
    }
    __device__ __forceinline__ void a_ready(const Unit&) const {}
    __device__ __forceinline__ void done(const Unit&) const {}
};
__device__ __forceinline__ unsigned cvt_pk_bf16(float lo, float hi) { unsigned r; asm volatile("v_cvt_pk_bf16_f32 %0, %1, %2" : "=v"(r) : "v"(lo), "v"(hi)); return r; }
typedef float f32x2 __attribute__((ext_vector_type(2)));
template <class Epi, class Sched, bool STAMP = false>
__device__ __forceinline__ void gemm_phase(PG8_LAS unsigned char* lds, const Gemm g, const Sched& S, const Epi& E, unsigned long long* stamps, const int tid) {
    const int wid = __builtin_amdgcn_readfirstlane(tid >> 6), lane = tid & 63, wr = wid >> 2, wc = wid & 3, fr = lane & 15, fq = lane >> 4;
    const int K = g.K, nt = K / BK;
    int ts_lo = 0, ts_hi = 0, nts = 0; const unsigned long long rt_entry = STAMP ? (unsigned long long)wall_clock64() : 0ull;
#define PG8_STAMP() do { if (STAMP && wid == 0 && nts < 64) { const unsigned long long _c = (unsigned long long)clock64(); \
        ts_lo = (lane == nts) ? (int)(unsigned)_c : ts_lo; ts_hi = (lane == nts) ? (int)(unsigned)(_c >> 32) : ts_hi; ++nts; } } while (0)
    PG8_STAMP();
    unsigned voffA[2], voffB[2];
#pragma unroll
    for (int i = 0; i < 2; ++i) { int R, C; stage_rc(tid * 16 + i * 8192, R, C); const int Rb = Epi::PERM ? ((R & ~31) + perm32(R & 31)) : R;
        voffA[i] = (unsigned)(R * K + C) * 2u; voffB[i] = (unsigned)(Rb * K + C) * 2u; }
    const size_t kstep = (size_t)(BK * 2);
    const size_t hstep = (size_t)HALF * K * 2;
    const size_t tstep = 2 * hstep;
    const unsigned ldsw = (unsigned)wid * 1024u;
    const int aoff = lds_byte(wr * 64 + fr, fq * 8), boff = lds_byte(wc * 32 + fr, fq * 8);
#define PG8_SA(b, h) (((b) * 2 + (h)) * HTB)
#define PG8_SB(b, h) ((4 + (b) * 2 + (h)) * HTB)
#define PG8_STAGE(bufoff, gbase, voff) do { _Pragma("unroll") for (int _i = 0; _i < 2; ++_i) \
        __builtin_amdgcn_global_load_lds((const unsigned*)((const char*)(gbase) + (voff)[_i]), (PG8_LAS unsigned*)(lds + (bufoff) + ldsw + _i * 8192), 16, 0, 0); } while (0)
#define PG8_LDA(dst, b, h) do { _Pragma("unroll") for (int m = 0; m < 4; ++m) _Pragma("unroll") for (int k = 0; k < 2; ++k) dst[m][k] = *(const PG8_LAS bf16x8*)(lds + PG8_SA(b, h) + aoff + m * 2048 + k * 1024); } while (0)
#define PG8_LDB(dst, b, h) do { _Pragma("unroll") for (int n = 0; n < 2; ++n) _Pragma("unroll") for (int k = 0; k < 2; ++k) dst[n][k] = *(const PG8_LAS bf16x8*)(lds + PG8_SB(b, h) + boff + n * 2048 + k * 1024); } while (0)
#define PG8_MMA(ai, bj, At, Bt) do { __builtin_amdgcn_s_setprio(1); _Pragma("unroll") for (int m = 0; m < 4; ++m) _Pragma("unroll") for (int n = 0; n < 2; ++n) _Pragma("unroll") for (int k = 0; k < 2; ++k) \
        acc[ai][bj][m][n] = __builtin_amdgcn_mfma_f32_16x16x32_bf16(Bt[n][k], At[m][k], acc[ai][bj][m][n], 0, 0, 0); __builtin_amdgcn_s_setprio(0); } while (0)
#define PG8_WAIT_V(n) asm volatile("s_waitcnt vmcnt(" #n ")" ::: "memory")
#define PG8_WAIT_L(n) asm volatile("s_waitcnt lgkmcnt(" #n ")" ::: "memory")
#define PG8_BAR __builtin_amdgcn_s_barrier()
#define PG8_SCHED __builtin_amdgcn_sched_barrier(0)
    Unit cur, nxt; int ui = 0;
    if (!S.next(0, cur)) return;
    f32x4 acc[2][2][4][2];
#pragma unroll
    for (int a = 0; a < 2; ++a)
#pragma unroll
        for (int b = 0; b < 2; ++b)
#pragma unroll
            for (int m = 0; m < 4; ++m)
#pragma unroll
                for (int n = 0; n < 2; ++n) acc[a][b][m][n] = (f32x4){0.f, 0.f, 0.f, 0.f};
    bf16x8 At[4][2], B0[2][2], B1[2][2];
    const char* cA = (const char*)g.A + (size_t)cur.pm * tstep; const char* cB = (const char*)g.Bt + (size_t)cur.pn * tstep;
    S.a_ready(cur);
    PG8_STAGE(PG8_SB(0, 0), cB, voffB); PG8_STAGE(PG8_SA(0, 0), cA, voffA); PG8_STAGE(PG8_SB(0, 1), cB + hstep, voffB); PG8_STAGE(PG8_SA(0, 1), cA + hstep, voffA);
    if (wr == 1) PG8_BAR;
    PG8_WAIT_V(4); PG8_BAR;
    PG8_STAGE(PG8_SB(1, 0), cB + kstep, voffB); PG8_STAGE(PG8_SA(1, 0), cA + kstep, voffA); PG8_STAGE(PG8_SB(1, 1), cB + hstep + kstep, voffB);
    PG8_WAIT_V(6); PG8_BAR;
    PG8_STAMP();
    for (;;) {
        const bool has_next = S.next(ui + 1, nxt);
        const char* nA = has_next ? (const char*)g.A + (size_t)nxt.pm * tstep : cA; const char* nB = has_next ? (const char*)g.Bt + (size_t)nxt.pn * tstep : cB;
        for (int t = 0; t < nt; t += 2) {
            const bool last = (t == nt - 2);
            const char* a1 = cA + (size_t)(t + 1) * kstep;
            const char* a2 = last ? nA : cA + (size_t)(t + 2) * kstep; const char* b2 = last ? nB : cB + (size_t)(t + 2) * kstep;
            const char* a3 = a2 + kstep; const char* b3 = b2 + kstep;
            if (last && has_next) S.a_ready(nxt);
            PG8_LDB(B0, 0, 0); PG8_SCHED; PG8_LDA(At, 0, 0); PG8_STAGE(PG8_SA(1, 1), a1 + hstep, voffA);
            PG8_WAIT_L(8); PG8_BAR; PG8_WAIT_L(0); PG8_MMA(0, 0, At, B0); PG8_BAR; PG8_SCHED;
            PG8_LDB(B1, 0, 1); PG8_STAGE(PG8_SB(0, 0), b2, voffB);
            PG8_BAR; PG8_WAIT_L(0); PG8_MMA(0, 1, At, B1); PG8_BAR;
            PG8_LDA(At, 0, 1); PG8_STAGE(PG8_SA(0, 0), a2, voffA);
            PG8_BAR; PG8_WAIT_L(0); PG8_MMA(1, 0, At, B0); PG8_BAR; PG8_SCHED;
            PG8_STAGE(PG8_SB(0, 1), b2 + hstep, voffB);
            PG8_WAIT_V(6); PG8_BAR; PG8_MMA(1, 1, At, B1); PG8_BAR;
            PG8_LDB(B0, 1, 0); PG8_SCHED; PG8_LDA(At, 1, 0); PG8_STAGE(PG8_SA(0, 1), a2 + hstep, voffA);
            PG8_WAIT_L(8); PG8_BAR; PG8_WAIT_L(0); PG8_MMA(0, 0, At, B0); PG8_BAR; PG8_SCHED;
            PG8_LDB(B1, 1, 1); PG8_STAGE(PG8_SB(1, 0), b3, voffB);
            PG8_BAR; PG8_WAIT_L(0); PG8_MMA(0, 1, At, B1); PG8_BAR;
            PG8_LDA(At, 1, 1); PG8_STAGE(PG8_SA(1, 0), a3, voffA);
            PG8_BAR; PG8_WAIT_L(0); PG8_MMA(1, 0, At, B0); PG8_BAR; PG8_SCHED;
            PG8_STAGE(PG8_SB(1, 1), b3 + hstep, voffB);
            PG8_WAIT_V(6); PG8_BAR; PG8_MMA(1, 1, At, B1); PG8_BAR;
        }
        PG8_STAMP();
        if constexpr (!Epi::AFTER_DRAIN) { E(acc, cur, wr, wc, fr, fq); S.done(cur); }
        PG8_STAMP();
        if (!has_next) break;
#pragma unroll
        for (int a = 0; a < 2; ++a)
#pragma unroll
            for (int b = 0; b < 2; ++b)
#pragma unroll
                for (int m = 0; m < 4; ++m)
#pragma unroll
                    for (int n = 0; n < 2; ++n) acc[a][b][m][n] = (f32x4){0.f, 0.f, 0.f, 0.f};
        cur = nxt; cA = nA; cB = nB; ++ui;
    }
    PG8_WAIT_V(0);
    if (wr == 0) PG8_BAR;
    PG8_BAR;
    if constexpr (Epi::AFTER_DRAIN) { E.fused(acc, cur, wr, wc, fr, fq, lds, wid, lane); S.done(cur); }
    PG8_STAMP();
    if (STAMP && wid == 0) { stamps[lane] = lane < nts ? (((unsigned long long)(unsigned)ts_hi << 32) | (unsigned)ts_lo) : 0ull;
        if (lane == 62) stamps[62] = rt_entry; if (lane == 63) stamps[63] = (unsigned long long)wall_clock64(); }
#undef PG8_STAMP
#undef PG8_SA
#undef PG8_SB
#undef PG8_STAGE
#undef PG8_LDA
#undef PG8_LDB
#undef PG8_MMA
#undef PG8_WAIT_V
#undef PG8_WAIT_L
#undef PG8_BAR
#undef PG8_SCHED
}
}

#define LAS __attribute__((address_space(3)))
using pg8::bf16_t; using pg8::bf16x8; using pg8::f32x4; using pg8::u32x4; using pg8::cvt_pk_bf16;
typedef short s16x4 __attribute__((ext_vector_type(4)));
typedef float f32x2 __attribute__((ext_vector_type(2)));
typedef float f32x16 __attribute__((ext_vector_type(16)));
typedef unsigned u32x2 __attribute__((ext_vector_type(2)));

constexpr int M_TOK = 32768, DM = 1024, SEQ = 2048, FF = 2816, NUP = 5632, EIN = 2304, OIN = 5120, NMOD = 9216;
constexpr float EPS = 1e-6f, LOG2E = 1.4426950408889634f;
constexpr int LDS_BYTES = 147456;
constexpr int N_PHASES = 45;
#ifndef PROBE_ATT_REP
#define PROBE_ATT_REP 1
#endif
#ifndef PROBE_HGRN_REP
#define PROBE_HGRN_REP 1
#endif
#ifndef PROBE_UP_REP
#define PROBE_UP_REP 1
#endif
#ifndef PROBE_PREP_REP
#define PROBE_PREP_REP 1
#endif
#ifndef PROBE_SYNC_REP
#define PROBE_SYNC_REP 1
#endif
#ifndef PROBE_DOWN_REP
#define PROBE_DOWN_REP 1
#endif
#ifndef PROBE_OUT_REP
#define PROBE_OUT_REP 1
#endif
#ifndef PROBE_IN_REP
#define PROBE_IN_REP 1
#endif
#ifndef PROBE_NORM_REP
#define PROBE_NORM_REP 1
#endif

constexpr size_t al256(size_t x) { return (x + 255) & ~(size_t)255; }
constexpr size_t WS_MOD = 0;
constexpr size_t WS_WUP = al256(WS_MOD + 4ull * 16 * NMOD * 4);
constexpr size_t WS_WDN = WS_WUP + 8ull * NUP * DM * 2;
constexpr size_t WS_WEIN = WS_WDN + 8ull * DM * FF * 2;
constexpr size_t WS_WEOUT = WS_WEIN + 2ull * EIN * DM * 2;
constexpr size_t WS_WOIN = WS_WEOUT + 2ull * DM * DM * 2;
constexpr size_t WS_WOOUT = WS_WOIN + 2ull * OIN * DM * 2;
constexpr size_t WS_H = WS_WOOUT + 2ull * DM * DM * 2;
constexpr size_t WS_Y = WS_H + (size_t)M_TOK * DM * 2;
constexpr size_t WS_R1 = WS_Y + (size_t)M_TOK * DM * 2;
constexpr size_t WS_O1 = WS_R1 + (size_t)M_TOK * OIN * 2;
constexpr size_t WS_BAR = WS_O1 + 512ull * 8 * 16 * 64 * 16;
constexpr size_t WS_END = WS_BAR + 16384;

struct Params {
    const float *x, *c, *ada_w, *ada_b, *norm_g, *ffn_up, *ffn_down, *even_w_in, *even_w_out, *qk_norm_g, *diff_lambda, *diff_subln_g, *sink_logit, *rel_bias,
        *odd_w_in, *odd_w_out, *c_lower_bound, *c_out_norm_g;
    float* out; unsigned char* ws; int ph_lo, ph_hi;
};

__device__ __forceinline__ float bf_lo(unsigned u) { return __uint_as_float(u << 16); }
__device__ __forceinline__ float bf_hi(unsigned u) { return __uint_as_float(u & 0xffff0000u); }
__device__ __forceinline__ float wave_sum(float v) {
#pragma unroll
    for (int o = 1; o < 64; o <<= 1) v += __shfl_xor(v, o);
    return v;
}
__device__ __forceinline__ float ex2(float v) { return __builtin_amdgcn_exp2f(v); }
__device__ __forceinline__ float silu_f(float a) { return a * __builtin_amdgcn_rcpf(1.f + ex2(-a * LOG2E)); }
__device__ __forceinline__ float sigm_f(float a) { return __builtin_amdgcn_rcpf(1.f + ex2(-a * LOG2E)); }

__device__ __forceinline__ unsigned swiglu_pk(f32x2 a, f32x2 b) {
    const f32x2 t = a * (-LOG2E);
    f32x2 e; e.x = ex2(t.x); e.y = ex2(t.y);
    const f32x2 d = e + 1.0f;
    f32x2 r; r.x = __builtin_amdgcn_rcpf(d.x); r.y = __builtin_amdgcn_rcpf(d.y);
    const f32x2 o = (a * b) * r;
    return cvt_pk_bf16(o.x, o.y);
}
struct EpiMulti {
    static constexpr bool PERM = true, AFTER_DRAIN = false;
    int mode; bf16_t* O; int ldc; const float* base; float* out; const float* gate; float coef; int presilu;
    __device__ __forceinline__ void operator()(const f32x4 (&acc)[2][2][4][2], const pg8::Unit& u, int wr, int wc, int fr, int fq) const {
        const int row0 = u.pm * 256 + wr * 64 + fr;
        if (mode == 0) {
            const int col0 = u.pn * 128 + wc * 32 + 8 * fq;
#pragma unroll
            for (int ai = 0; ai < 2; ++ai)
#pragma unroll
                for (int m = 0; m < 4; ++m) {
                    bf16_t* rowp = O + (size_t)(row0 + ai * 128 + m * 16) * FF + col0;
                    const f32x4 a0 = acc[ai][0][m][0], a1 = acc[ai][0][m][1], b0 = acc[ai][1][m][0], b1 = acc[ai][1][m][1];
                    u32x4 w;
                    w.x = swiglu_pk((f32x2){a0[0], a0[1]}, (f32x2){b0[0], b0[1]}); w.y = swiglu_pk((f32x2){a0[2], a0[3]}, (f32x2){b0[2], b0[3]});
                    w.z = swiglu_pk((f32x2){a1[0], a1[1]}, (f32x2){b1[0], b1[1]}); w.w = swiglu_pk((f32x2){a1[2], a1[3]}, (f32x2){b1[2], b1[3]});
                    *(u32x4*)rowp = w;
                    asm volatile("" ::: "memory");
                }
        } else if (mode == 1) {
            const int col0 = u.pn * 256 + wc * 32 + 8 * fq, b = u.pm >> 3;
#pragma unroll
            for (int bj = 0; bj < 2; ++bj) {
                const f32x4 g0 = *(const f32x4*)(gate + (size_t)b * NMOD + col0 + bj * 128) * coef, g1 = *(const f32x4*)(gate + (size_t)b * NMOD + col0 + bj * 128 + 4) * coef;
                const unsigned rb = (unsigned)row0 * DM + (unsigned)(col0 + bj * 128);
#pragma unroll
                for (int ai = 0; ai < 2; ++ai) {
                    f32x4 bs[4][2];
#pragma unroll
                    for (int m = 0; m < 4; ++m) {
                        const unsigned off = rb + (unsigned)((ai * 128 + m * 16) * DM);
                        bs[m][0] = *(const f32x4*)(base + off); bs[m][1] = *(const f32x4*)(base + off + 4);
                    }
#pragma unroll
                    for (int m = 0; m < 4; ++m) {
                        const unsigned off = rb + (unsigned)((ai * 128 + m * 16) * DM);
                        *(f32x4*)(out + off) = bs[m][0] + g0 * acc[ai][bj][m][0];
                        *(f32x4*)(out + off + 4) = bs[m][1] + g1 * acc[ai][bj][m][1];
                    }
                    asm volatile("" ::: "memory");
                }
            }
        } else if (mode == 3) {
            const int head = u.pn * 4 + wc;
            const int set = head < 8 ? 0 : head < 16 ? 1 : head < 24 ? -1 : head < 32 ? 2 : head < 34 ? 3 : -1;
            bf16_t* obase = O + head * 64 + 8 * fq;
            if (set >= 0) {
                const float qs = (set == 0 || set == 2) ? 0.125f * LOG2E : 1.0f;
                f32x4 gq[2][2];
#pragma unroll
                for (int bj = 0; bj < 2; ++bj)
#pragma unroll
                    for (int n = 0; n < 2; ++n) gq[bj][n] = *(const f32x4*)(gate + set * 64 + bj * 32 + 8 * fq + 4 * n);
#pragma unroll
                for (int ai = 0; ai < 2; ++ai)
#pragma unroll
                    for (int m = 0; m < 4; ++m) {
                        float ss = 0.f;
#pragma unroll
                        for (int bj = 0; bj < 2; ++bj)
#pragma unroll
                            for (int n = 0; n < 2; ++n) { const f32x4 v = acc[ai][bj][m][n]; ss += (v[0] * v[0] + v[1] * v[1]) + (v[2] * v[2] + v[3] * v[3]); }
                        ss += __shfl_xor(ss, 16); ss += __shfl_xor(ss, 32);
                        const float rstd = qs / sqrtf(ss * (1.0f / 64.0f) + EPS);
                        bf16_t* rowp = obase + (size_t)(row0 + ai * 128 + m * 16) * EIN;
#pragma unroll
                        for (int bj = 0; bj < 2; ++bj) {
                            const f32x4 v0 = acc[ai][bj][m][0] * rstd * gq[bj][0], v1 = acc[ai][bj][m][1] * rstd * gq[bj][1];
                            u32x4 w; w.x = cvt_pk_bf16(v0[0], v0[1]); w.y = cvt_pk_bf16(v0[2], v0[3]); w.z = cvt_pk_bf16(v1[0], v1[1]); w.w = cvt_pk_bf16(v1[2], v1[3]);
                            *(u32x4*)(rowp + bj * 32) = w;
                        }
                    }
            } else {
#pragma unroll
                for (int ai = 0; ai < 2; ++ai)
#pragma unroll
                    for (int m = 0; m < 4; ++m) {
                        bf16_t* rowp = obase + (size_t)(row0 + ai * 128 + m * 16) * EIN;
#pragma unroll
                        for (int bj = 0; bj < 2; ++bj) {
                            const f32x4 v0 = acc[ai][bj][m][0], v1 = acc[ai][bj][m][1];
                            u32x4 w; w.x = cvt_pk_bf16(v0[0], v0[1]); w.y = cvt_pk_bf16(v0[2], v0[3]); w.z = cvt_pk_bf16(v1[0], v1[1]); w.w = cvt_pk_bf16(v1[2], v1[3]);
                            *(u32x4*)(rowp + bj * 32) = w;
                        }
                    }
            }
        } else {
            const int col0 = u.pn * 256 + wc * 32 + 8 * fq;
#pragma unroll
            for (int ai = 0; ai < 2; ++ai)
#pragma unroll
                for (int m = 0; m < 4; ++m) {
                    bf16_t* rowp = O + (size_t)(row0 + ai * 128 + m * 16) * ldc + col0;
#pragma unroll
                    for (int bj = 0; bj < 2; ++bj) {
                        f32x4 v0 = acc[ai][bj][m][0], v1 = acc[ai][bj][m][1];
                        if (presilu && u.pn < 4) {
#pragma unroll
                            for (int e2 = 0; e2 < 4; ++e2) { v0[e2] = silu_f(v0[e2]); v1[e2] = silu_f(v1[e2]); } }
                        u32x4 w; w.x = cvt_pk_bf16(v0[0], v0[1]); w.y = cvt_pk_bf16(v0[2], v0[3]); w.z = cvt_pk_bf16(v1[0], v1[1]); w.w = cvt_pk_bf16(v1[2], v1[3]);
                        *(u32x4*)(rowp + bj * 128) = w;
                    }
                }
        }
    }
};

__device__ __forceinline__ void tr_item(const float* __restrict__ W, int K, int N, bf16_t* __restrict__ WT, int dst_n0, int src_n0, int k0, LAS float* scr, int lane) {
    {
        f32x4 v[8]; const int r8 = lane >> 3, c4 = (lane & 7) * 4;
#pragma unroll
        for (int i = 0; i < 8; ++i) v[i] = *(const f32x4*)(W + (size_t)(k0 + 8 * i + r8) * N + src_n0 + c4);
#pragma unroll
        for (int i = 0; i < 8; ++i) { LAS float* d = scr + (8 * i + r8) * 33 + c4; d[0] = v[i][0]; d[1] = v[i][1]; d[2] = v[i][2]; d[3] = v[i][3]; }
    }
    asm volatile("s_waitcnt lgkmcnt(0)" ::: "memory");
    const int c = lane & 7;
#pragma unroll
    for (int j = 0; j < 4; ++j) {
        const int n = (lane >> 3) + 8 * j; const LAS float* s = scr + (8 * c) * 33 + n;
        u32x4 o; o.x = cvt_pk_bf16(s[0 * 33], s[1 * 33]); o.y = cvt_pk_bf16(s[2 * 33], s[3 * 33]); o.z = cvt_pk_bf16(s[4 * 33], s[5 * 33]); o.w = cvt_pk_bf16(s[6 * 33], s[7 * 33]);
        *(u32x4*)(WT + (size_t)(dst_n0 + n) * K + k0 + 8 * c) = o;
    }
    asm volatile("s_waitcnt lgkmcnt(0)" ::: "memory");
}

__device__ __forceinline__ void prep_phase(const Params& p, LAS unsigned char* lds, int tid, int bx, int gdim) {
    const int lane = tid & 63, wave = tid >> 6;
    const int gw = bx * 8 + wave, ngw = gdim * 8;
    unsigned char* ws = p.ws;
    {
        LAS float* scr = (LAS float*)(lds + wave * 16384);
        constexpr int I_UP = 8 * 16 * 176, I_DN = 8 * 44 * 32, I_EI = 2 * 16 * 72, I_EO = 2 * 16 * 32, I_OI = 2 * 16 * 160, I_OO = 2 * 16 * 32;
        constexpr int NITEMS = I_UP + I_DN + I_EI + I_EO + I_OI + I_OO;
        for (int it = gw; it < NITEMS; it += ngw) {
            int r = it;
            if (r < I_UP) { const int mat = r / 2816, q = r % 2816, kb = q / 176, nb = q % 176, dn0 = nb * 32; const int src = ((dn0 >> 7) & 1) * FF + (dn0 >> 8) * 128 + (dn0 & 127);
                tr_item(p.ffn_up + (size_t)mat * DM * NUP, DM, NUP, (bf16_t*)(ws + WS_WUP) + (size_t)mat * NUP * DM, dn0, src, kb * 64, scr, lane); continue; }
            r -= I_UP;
            if (r < I_DN) { const int mat = r / 1408, q = r % 1408, kb = q / 32, nb = q % 32;
                tr_item(p.ffn_down + (size_t)mat * FF * DM, FF, DM, (bf16_t*)(ws + WS_WDN) + (size_t)mat * DM * FF, nb * 32, nb * 32, kb * 64, scr, lane); continue; }
            r -= I_DN;
            if (r < I_EI) { const int mat = r / 1152, q = r % 1152, kb = q / 72, nb = q % 72;
                const int dn0 = nb * 32, src = (4 * (dn0 >> 8) + ((dn0 >> 5) & 3)) * 64 + 32 * ((dn0 >> 7) & 1);
                tr_item(p.even_w_in + (size_t)mat * DM * EIN, DM, EIN, (bf16_t*)(ws + WS_WEIN) + (size_t)mat * EIN * DM, dn0, src, kb * 64, scr, lane); continue; }
            r -= I_EI;
            if (r < I_EO) { const int mat = r / 512, q = r % 512, kb = q / 32, nb = q % 32;
                tr_item(p.even_w_out + (size_t)mat * DM * DM, DM, DM, (bf16_t*)(ws + WS_WEOUT) + (size_t)mat * DM * DM, nb * 32, nb * 32, kb * 64, scr, lane); continue; }
            r -= I_EO;
            if (r < I_OI) { const int mat = r / 2560, q = r % 2560, kb = q / 160, nb = q % 160;
                tr_item(p.odd_w_in + (size_t)mat * DM * OIN, DM, OIN, (bf16_t*)(ws + WS_WOIN) + (size_t)mat * OIN * DM, nb * 32, nb * 32, kb * 64, scr, lane); continue; }
            r -= I_OI;
            { const int mat = r / 512, q = r % 512, kb = q / 32, nb = q % 32;
                tr_item(p.odd_w_out + (size_t)mat * DM * DM, DM, DM, (bf16_t*)(ws + WS_WOOUT) + (size_t)mat * DM * DM, nb * 32, nb * 32, kb * 64, scr, lane); }
        }
    }
    __syncthreads();
    {
        LAS float* sc = (LAS float*)lds;
        LAS float* red = (LAS float*)(lds + 65536);
        float* mod = (float*)(ws + WS_MOD);
        for (int i = tid; i < 16 * 1024; i += 512) { const int b = i >> 10, k = i & 1023; sc[k * 16 + b] = silu_f(p.c[i]); }
        __syncthreads();
        const int cl = tid & 127, kq = tid >> 7;
        for (int unit = bx; unit < 288; unit += gdim) {
            const int l = unit / 72, n0 = (unit % 72) * 128;
            const float* w = p.ada_w + (size_t)l * DM * NMOD + n0 + cl;
            float acc[16];
#pragma unroll
            for (int b = 0; b < 16; ++b) acc[b] = 0.f;
#pragma unroll 4
            for (int k = kq * 256; k < kq * 256 + 256; ++k) {
                const float wv = w[(size_t)k * NMOD];
                const LAS f32x4* s4 = (const LAS f32x4*)(sc + k * 16);
                const f32x4 s0 = s4[0], s1 = s4[1], s2 = s4[2], s3 = s4[3];
                acc[0] += s0[0] * wv; acc[1] += s0[1] * wv; acc[2] += s0[2] * wv; acc[3] += s0[3] * wv;
                acc[4] += s1[0] * wv; acc[5] += s1[1] * wv; acc[6] += s1[2] * wv; acc[7] += s1[3] * wv;
                acc[8] += s2[0] * wv; acc[9] += s2[1] * wv; acc[10] += s2[2] * wv; acc[11] += s2[3] * wv;
                acc[12] += s3[0] * wv; acc[13] += s3[1] * wv; acc[14] += s3[2] * wv; acc[15] += s3[3] * wv;
            }
#pragma unroll
            for (int b = 0; b < 16; ++b) red[(kq * 16 + b) * 128 + cl] = acc[b];
            __syncthreads();
            for (int o = tid; o < 2048; o += 512) {
                const int b = o >> 7, cc = o & 127;
                const float v = red[(0 * 16 + b) * 128 + cc] + red[(1 * 16 + b) * 128 + cc] + red[(2 * 16 + b) * 128 + cc] + red[(3 * 16 + b) * 128 + cc] + p.ada_b[(size_t)l * NMOD + n0 + cc];
                mod[((size_t)l * 16 + b) * NMOD + n0 + cc] = v;
            }
            __syncthreads();
        }
    }
}

__device__ __forceinline__ void norm_phase(const float* __restrict__ xin, const float* __restrict__ g, const float* __restrict__ modl, int shift_idx, bf16_t* __restrict__ h, int tid, int bx, int gdim) {
    const int lane = tid & 63, wave = tid >> 6;
    const int gw = bx * 8 + wave, ngw = gdim * 8;
    const int rpw = (M_TOK + ngw - 1) / ngw;
    int r0 = gw * rpw, r1 = r0 + rpw; if (r1 > M_TOK) r1 = M_TOK;
    f32x4 A[4], Bc[4]; int bcur = -1;
    for (int r = r0; r < r1;) {
        const int b = r / SEQ;
        if (b != bcur) {
            bcur = b;
#pragma unroll
            for (int j = 0; j < 4; ++j) {
                const int col = 4 * lane + 256 * j;
                const f32x4 gv = *(const f32x4*)(g + col), sc = *(const f32x4*)(modl + (size_t)b * NMOD + (shift_idx + 1) * 1024 + col), sh = *(const f32x4*)(modl + (size_t)b * NMOD + shift_idx * 1024 + col);
                A[j] = gv * (sc + 1.0f); Bc[j] = sh;
            }
        }
        const bool two = (r + 1 < r1) && ((r + 1) / SEQ == b);
        const f32x4* xr = (const f32x4*)(xin + (size_t)r * DM) + lane;
        const f32x4* xr2 = (const f32x4*)(xin + (size_t)(two ? r + 1 : r) * DM) + lane;
        f32x4 v[4], v2[4]; float ss = 0.f, ss2 = 0.f;
#pragma unroll
        for (int j = 0; j < 4; ++j) { v[j] = xr[64 * j]; v2[j] = xr2[64 * j]; }
#pragma unroll
        for (int j = 0; j < 4; ++j) { ss += (v[j][0] * v[j][0] + v[j][1] * v[j][1]) + (v[j][2] * v[j][2] + v[j][3] * v[j][3]); ss2 += (v2[j][0] * v2[j][0] + v2[j][1] * v2[j][1]) + (v2[j][2] * v2[j][2] + v2[j][3] * v2[j][3]); }
        ss = wave_sum(ss); ss2 = wave_sum(ss2);
        const float rstd = 1.0f / sqrtf(ss * (1.0f / DM) + EPS), rstd2 = 1.0f / sqrtf(ss2 * (1.0f / DM) + EPS);
        u32x2* o8 = (u32x2*)(h + (size_t)r * DM) + lane;
#pragma unroll
        for (int j = 0; j < 4; ++j) { const f32x4 y = v[j] * rstd * A[j] + Bc[j]; u32x2 w; w.x = cvt_pk_bf16(y[0], y[1]); w.y = cvt_pk_bf16(y[2], y[3]); o8[64 * j] = w; }
        if (two) {
            u32x2* o82 = (u32x2*)(h + (size_t)(r + 1) * DM) + lane;
#pragma unroll
            for (int j = 0; j < 4; ++j) { const f32x4 y = v2[j] * rstd2 * A[j] + Bc[j]; u32x2 w; w.x = cvt_pk_bf16(y[0], y[1]); w.y = cvt_pk_bf16(y[2], y[3]); o82[64 * j] = w; }
        }
        r += two ? 2 : 1;
    }
}

__device__ __forceinline__ void qknorm_phase(bf16_t* qkv, const float* __restrict__ qkg, int tid, int bx, int gdim) {
    const int lane = tid & 63, wave = tid >> 6;
    const int gw = bx * 8 + wave, ngw = gdim * 8;
    const int sub = lane >> 3, c8 = (lane & 7) * 8;
    for (int m = gw; m < M_TOK; m += ngw) {
        bf16_t* row = qkv + (size_t)m * EIN;
#pragma unroll
        for (int rd = 0; rd < 4; ++rd) {
            const int vi = rd * 8 + sub; const bool act = vi < 26;
            int col, gs; float qs = 1.0f;
            if (vi < 8) { col = vi * 64; gs = 0; qs = 0.125f * LOG2E; }
            else if (vi < 16) { col = 512 + (vi - 8) * 64; gs = 1; }
            else if (vi < 24) { col = 1536 + (vi - 16) * 64; gs = 2; qs = 0.125f * LOG2E; }
            else { col = 2048 + ((vi - 24) & 1) * 64; gs = 3; }
            u32x4 raw = (u32x4){0u, 0u, 0u, 0u};
            if (act) raw = *(const u32x4*)(row + col + c8);
            float f[8] = {bf_lo(raw.x), bf_hi(raw.x), bf_lo(raw.y), bf_hi(raw.y), bf_lo(raw.z), bf_hi(raw.z), bf_lo(raw.w), bf_hi(raw.w)};
            float ss = 0.f;
#pragma unroll
            for (int e = 0; e < 8; ++e) ss += f[e] * f[e];
            ss += __shfl_xor(ss, 1); ss += __shfl_xor(ss, 2); ss += __shfl_xor(ss, 4);
            const float rstd = qs / sqrtf(ss * (1.0f / 64.0f) + EPS);
            const f32x4 g0 = *(const f32x4*)(qkg + gs * 64 + c8), g1 = *(const f32x4*)(qkg + gs * 64 + c8 + 4);
            u32x4 w;
            w.x = cvt_pk_bf16(f[0] * rstd * g0[0], f[1] * rstd * g0[1]); w.y = cvt_pk_bf16(f[2] * rstd * g0[2], f[3] * rstd * g0[3]);
            w.z = cvt_pk_bf16(f[4] * rstd * g1[0], f[5] * rstd * g1[1]); w.w = cvt_pk_bf16(f[6] * rstd * g1[2], f[7] * rstd * g1[3]);
            if (act) *(u32x4*)(row + col + c8) = w;
        }
    }
}

constexpr int A_K0 = 0, A_KS = 8192, A_V0 = 16384, A_VS = 16384, A_LUT_OFF = 49152, A_Q_OFF = A_LUT_OFF + 4096;
__device__ __forceinline__ int t5_bucket(int rel) {
    const int n = rel < 0 ? -rel : rel; int b = rel > 0 ? 16 : 0;
    if (n < 8) b += n; else { const int v = 2 + (31 - __builtin_clz((unsigned)(n * n))); b += v < 15 ? v : 15; }
    return b;
}
__device__ __forceinline__ s16x4 tr16(const LAS unsigned char* p) {
    typedef short v4i16_t __attribute__((ext_vector_type(4)));
    return __builtin_bit_cast(s16x4, __builtin_amdgcn_ds_read_tr16_b64_v4i16((LAS v4i16_t*)p));
}
__device__ __forceinline__ int crow(int r, int hi) { return (r & 3) + 8 * (r >> 2) + 4 * hi; }
__device__ __forceinline__ u32x4 pair_swap(u32x2 a, u32x2 b) {
    const auto s0 = __builtin_amdgcn_permlane32_swap(a.x, b.x, false, false), s1 = __builtin_amdgcn_permlane32_swap(a.y, b.y, false, false);
    return (u32x4){s0[0], s1[0], s0[1], s1[1]};
}
template <int OFF> __device__ __forceinline__ s16x4 tr16a(unsigned a) { s16x4 r; asm volatile("ds_read_b64_tr_b16 %0, %1 offset:%2" : "=&v"(r) : "v"(a), "i"(OFF) : "memory"); return r; }
template <int DV, int H> __device__ __forceinline__ void v_half(unsigned a, s16x4 (&G)[4]) {
    constexpr int KS = (DV == 128) ? (H >> 1) : H, D0 = (DV == 128) ? 2 * (H & 1) : 0;
    G[0] = tr16a<D0 * 4096 + KS * 1024>(a); G[1] = tr16a<D0 * 4096 + KS * 1024 + 512>(a);
    G[2] = tr16a<(D0 + 1) * 4096 + KS * 1024>(a); G[3] = tr16a<(D0 + 1) * 4096 + KS * 1024 + 512>(a);
}
template <int N> __device__ __forceinline__ void v_wait4(s16x4 (&G)[4]) {
    asm volatile("s_waitcnt lgkmcnt(%4)" : "+v"(G[0]), "+v"(G[1]), "+v"(G[2]), "+v"(G[3]) : "i"(N) : "memory");
}
template <int DV, int H> __device__ __forceinline__ void v_mma(f32x16 (&o)[DV / 32], const s16x4 (&G)[4], const u32x4 (&pw)[4]) {
    constexpr int KS = (DV == 128) ? (H >> 1) : H, D0 = (DV == 128) ? 2 * (H & 1) : 0;
    const bf16x8 f0 = (bf16x8){G[0][0], G[0][1], G[0][2], G[0][3], G[1][0], G[1][1], G[1][2], G[1][3]}, f1 = (bf16x8){G[2][0], G[2][1], G[2][2], G[2][3], G[3][0], G[3][1], G[3][2], G[3][3]};
    o[D0] = __builtin_amdgcn_mfma_f32_32x32x16_bf16(f0, __builtin_bit_cast(bf16x8, pw[KS]), o[D0], 0, 0, 0);
    o[D0 + 1] = __builtin_amdgcn_mfma_f32_32x32x16_bf16(f1, __builtin_bit_cast(bf16x8, pw[KS]), o[D0 + 1], 0, 0, 0);
}
template <int DV, bool WIN>
__device__ __forceinline__ void attn_stream(LAS unsigned char* lds, const bf16_t* __restrict__ Kg, const bf16_t* __restrict__ Vg, const LAS unsigned char* qfp, int qw, int t0, int t1,
                                            float& m_run, float& l_run, f32x16 (&o)[DV / 32], int tid) {
    const int lane = tid & 63, r32 = lane & 31, hi = lane >> 5;
    const LAS float* lut = (const LAS float*)(lds + A_LUT_OFF);
    constexpr int VP = DV / 64, CPK = DV / 8;
    const int wid = __builtin_amdgcn_readfirstlane(tid >> 6);
    const unsigned koff = (unsigned)(lane * EIN + wid * 8);
    const LAS unsigned char* kb0 = lds + A_K0 + hi * 1024 + r32 * 16;
    const LAS unsigned char* vb0 = lds + A_V0 + ((lane >> 4) & 1) * 32 + (lane & 3) * 8 + (4 * hi + ((lane & 15) >> 2)) * 64;
#define ATT_DK(tt, sl) do { __builtin_amdgcn_global_load_lds((const unsigned*)(Kg + (size_t)(tt) * 64 * EIN + koff), (LAS unsigned*)(lds + A_K0 + (sl) * A_KS + wid * 1024), 16, 0, 0); } while (0)
#define ATT_DV(tt, sl) do { const bf16_t* vbase_ = Vg + (size_t)(tt) * 64 * EIN; \
    _Pragma("unroll") for (int j = 0; j < VP; ++j) { const int pc = wid + 8 * j; \
        __builtin_amdgcn_global_load_lds((const unsigned*)(vbase_ + (unsigned)((16 * (pc & 3) + (lane >> 2)) * EIN + (pc >> 2) * 32 + (lane & 3) * 8)), (LAS unsigned*)(lds + A_V0 + (sl) * A_VS + pc * 1024), 16, 0, 0); } } while (0)
#define ATT_QK4(FIRST0, FIRST1, P0, P1) do { _Pragma("unroll") for (int d0 = 0; d0 < 4; ++d0) { \
            const bf16x8 b0 = *(const LAS bf16x8*)(kbp_ + d0 * 2048), b1 = *(const LAS bf16x8*)(kbp_ + d0 * 2048 + 512); \
            const bf16x8 qv = *(const LAS bf16x8*)(qfp + d0 * 1024); \
            P0 = __builtin_amdgcn_mfma_f32_32x32x16_bf16(b0, qv, d0 == 0 ? (FIRST0) : P0, 0, 0, 0); \
            P1 = __builtin_amdgcn_mfma_f32_32x32x16_bf16(b1, qv, d0 == 0 ? (FIRST1) : P1, 0, 0, 0); } } while (0)
#define ATT_QKT(tt, P0, P1, CB) do { const int k0_ = (tt) * 64, relmin_ = k0_ - (qw + 31), relmax_ = k0_ + 63 - qw; \
        const LAS unsigned char* kbp_ = kb0 + (((tt) - t0) & 1) * A_KS; \
        if (!WIN && (relmin_ >= 91 || relmax_ <= -91)) { CB = (relmin_ >= 91) ? lut[224 + 128] : lut[224 - 128]; \
            const f32x16 z_ = {0.f, 0.f, 0.f, 0.f, 0.f, 0.f, 0.f, 0.f, 0.f, 0.f, 0.f, 0.f, 0.f, 0.f, 0.f, 0.f}; ATT_QK4(z_, z_, P0, P1); } \
        else { CB = 0.f; f32x16 i0_, i1_; const LAS float* lp_ = lut + (k0_ - qw - r32 + 4 * hi + 224); \
            _Pragma("unroll") for (int r = 0; r < 16; ++r) { i0_[r] = lp_[(r & 3) + 8 * (r >> 2)]; i1_[r] = lp_[(r & 3) + 8 * (r >> 2) + 32]; } \
            ATT_QK4(i0_, i1_, P0, P1); } } while (0)
#define ATT_SPV(tt, P0, P1, CB) do { \
        const float mref_ = m_run - CB; float rs_ = 0.f;     \
        _Pragma("unroll") for (int r = 0; r < 16; ++r) { P0[r] = ex2(P0[r] - mref_); P1[r] = ex2(P1[r] - mref_); rs_ += P0[r] + P1[r]; } \
        l_run += rs_; \
        u32x4 pw_[4]; \
        _Pragma("unroll") for (int k = 0; k < 2; ++k) { \
            pw_[k] = (u32x4){cvt_pk_bf16(P0[8 * k + 0], P0[8 * k + 1]), cvt_pk_bf16(P0[8 * k + 2], P0[8 * k + 3]), cvt_pk_bf16(P0[8 * k + 4], P0[8 * k + 5]), cvt_pk_bf16(P0[8 * k + 6], P0[8 * k + 7])}; \
            pw_[2 + k] = (u32x4){cvt_pk_bf16(P1[8 * k + 0], P1[8 * k + 1]), cvt_pk_bf16(P1[8 * k + 2], P1[8 * k + 3]), cvt_pk_bf16(P1[8 * k + 4], P1[8 * k + 5]), cvt_pk_bf16(P1[8 * k + 6], P1[8 * k + 7])}; } \
        const LAS unsigned char* vbp_ = vb0 + (((tt) - t0) & 1) * A_VS; \
        __builtin_amdgcn_sched_barrier(0); \
        { const unsigned va_ = (unsigned)(size_t)vbp_; s16x4 g0_[4], g1_[4], g2_[4];     \
          v_half<DV, 0>(va_, g0_); v_half<DV, 1>(va_, g1_); \
          v_half<DV, 2>(va_, g2_); v_wait4<8>(g0_); v_mma<DV, 0>(o, g0_, pw_); __builtin_amdgcn_sched_barrier(0); \
          v_half<DV, 3>(va_, g0_); v_wait4<8>(g1_); v_mma<DV, 1>(o, g1_, pw_); __builtin_amdgcn_sched_barrier(0); \
          if constexpr (DV == 128) { \
              v_half<DV, 4>(va_, g1_); v_wait4<8>(g2_); v_mma<DV, 2>(o, g2_, pw_); __builtin_amdgcn_sched_barrier(0); \
              v_half<DV, 5>(va_, g2_); v_wait4<8>(g0_); v_mma<DV, 3>(o, g0_, pw_); __builtin_amdgcn_sched_barrier(0); \
              v_half<DV, 6>(va_, g0_); v_wait4<8>(g1_); v_mma<DV, 4>(o, g1_, pw_); __builtin_amdgcn_sched_barrier(0); \
              v_half<DV, 7>(va_, g1_); v_wait4<8>(g2_); v_mma<DV, 5>(o, g2_, pw_); __builtin_amdgcn_sched_barrier(0); \
              v_wait4<4>(g0_); v_mma<DV, 6>(o, g0_, pw_); __builtin_amdgcn_sched_barrier(0); \
              v_wait4<0>(g1_); v_mma<DV, 7>(o, g1_, pw_); __builtin_amdgcn_sched_barrier(0); \
          } else { \
              v_wait4<4>(g2_); v_mma<DV, 2>(o, g2_, pw_); __builtin_amdgcn_sched_barrier(0); \
              v_wait4<0>(g0_); v_mma<DV, 3>(o, g0_, pw_); __builtin_amdgcn_sched_barrier(0); \
          } } } while (0)
#define ATT_STEP(tt, PA0, PA1, CBA, PB0, PB1, CBB) do { \
        asm volatile("s_waitcnt vmcnt(0)" ::: "memory"); __syncthreads(); \
        if ((tt) + 2 < t1) ATT_DK((tt) + 2, ((tt) - t0) & 1); \
        if ((tt) + 1 < t1) ATT_DV((tt) + 1, ((tt) + 1 - t0) & 1); \
        if ((tt) + 1 < t1 && !(WIN && (((tt) + 1) * 64 - (qw + 31) > 128 || ((tt) + 1) * 64 + 63 - qw < -128))) ATT_QKT((tt) + 1, PB0, PB1, CBB); \
        if (!(WIN && ((tt) * 64 - (qw + 31) > 128 || (tt) * 64 + 63 - qw < -128))) ATT_SPV(tt, PA0, PA1, CBA); } while (0)
    __syncthreads();
    ATT_DK(t0, 0); ATT_DV(t0, 0);
    if (t0 + 1 < t1) ATT_DK(t0 + 1, 1);
    asm volatile("s_waitcnt vmcnt(0)" ::: "memory"); __syncthreads();
    f32x16 pA0, pA1, pB0, pB1; float cbA = 0.f, cbB = 0.f;
    if (!(WIN && (t0 * 64 - (qw + 31) > 128 || t0 * 64 + 63 - qw < -128))) ATT_QKT(t0, pA0, pA1, cbA);
    for (int t = t0; t < t1; t += 2) {
        ATT_STEP(t, pA0, pA1, cbA, pB0, pB1, cbB);
        if (t + 1 < t1) ATT_STEP(t + 1, pB0, pB1, cbB, pA0, pA1, cbA);
    }
#undef ATT_DK
#undef ATT_DV
#undef ATT_QK4
#undef ATT_QKT
#undef ATT_SPV
#undef ATT_STEP
}
__device__ __forceinline__ void build_lut(LAS unsigned char* lds, const float* __restrict__ rel_bias, int head, bool win, int tid) {
    LAS float* lut = (LAS float*)(lds + A_LUT_OFF);
    __syncthreads();
    if (tid < 449) { const int rel = tid - 224; float v = rel_bias[t5_bucket(rel) * 12 + head] * LOG2E; if (win && (rel < -128 || rel > 128)) v = -INFINITY; lut[tid] = v; }
}

__device__ __forceinline__ void attn_phase(const Params& p, LAS unsigned char* lds, int layer, int tid, int bx0, int gdim) {
    const int lane = tid & 63, r32 = lane & 31, hi = lane >> 5, wid = tid >> 6;
    const int e = layer >> 1;
    const bf16_t* qkv = (const bf16_t*)(p.ws + WS_R1);
    bf16_t* yb = (bf16_t*)(p.ws + WS_Y);
    const int G = gdim, bx = bx0;
    const int vcu = (G % 8 == 0) ? (bx % 8) * (G / 8) + bx / 8 : bx;
    float mfix;
    { const float* qg = p.qk_norm_g + e * 256; float ga = fabsf(qg[lane]), gb = fabsf(qg[64 + lane]);
#pragma unroll
      for (int o2 = 1; o2 < 64; o2 <<= 1) { ga = fmaxf(ga, __shfl_xor(ga, o2)); gb = fmaxf(gb, __shfl_xor(gb, o2)); }
      mfix = 0.125f * LOG2E * 64.0f * ga * gb * 1.02f + 1.0f; }
    const float lam_init = 0.8f - 0.6f * expf(-0.3f * (float)layer);
    float lam;
    { const float* lp = p.diff_lambda + e * 256; const float s01 = wave_sum(lp[lane] * lp[64 + lane]), s23 = wave_sum(lp[128 + lane] * lp[192 + lane]); lam = expf(s01) - expf(s23) + lam_init; }
#ifndef NO_DIFF
    for (int unit = vcu; unit < 512; unit += G) {
        const int qb = unit & 7, h = (unit >> 3) & 3, b = unit >> 5;
        build_lut(lds, p.rel_bias, h, false, tid);
        const int qw = qb * 256 + wid * 32;
        const bf16_t* qkv_b = qkv + (size_t)b * SEQ * EIN;
        f32x4* stash = (f32x4*)(p.ws + WS_O1) + ((size_t)(bx * 8 + wid) * 16) * 64 + lane;
#pragma unroll 1
        for (int s = 0; s < 2; ++s) {
            LAS unsigned char* qfp = lds + A_Q_OFF + wid * 4096 + hi * 512 + r32 * 16;
#pragma unroll
            for (int d0 = 0; d0 < 4; ++d0) *(LAS bf16x8*)(qfp + d0 * 1024) = *(const bf16x8*)(qkv_b + (size_t)(qw + r32) * EIN + h * 128 + s * 64 + d0 * 16 + hi * 8);
            f32x16 o[4];
#pragma unroll
            for (int db = 0; db < 4; ++db)
#pragma unroll
                for (int r = 0; r < 16; ++r) o[db][r] = 0.f;
            float m_run = mfix, l_run = 0.f;
            attn_stream<128, false>(lds, qkv_b + 512 + h * 128 + s * 64, qkv_b + 1024 + h * 128, qfp, qw, 0, SEQ / 64, m_run, l_run, o, tid);
            const float lt = l_run + __shfl_xor(l_run, 32), inv = 1.0f / lt;
            if (s == 0) {
#pragma unroll
                for (int db = 0; db < 4; ++db)
#pragma unroll
                    for (int g4 = 0; g4 < 4; ++g4) stash[(db * 4 + g4) * 64] = (f32x4){o[db][4 * g4 + 0] * inv, o[db][4 * g4 + 1] * inv, o[db][4 * g4 + 2] * inv, o[db][4 * g4 + 3] * inv};
            } else {
                const float li = lam * inv; float ss = 0.f;
#pragma unroll
                for (int db = 0; db < 4; ++db)
#pragma unroll
                    for (int g4 = 0; g4 < 4; ++g4) { const f32x4 a = stash[(db * 4 + g4) * 64];
#pragma unroll
                        for (int e2 = 0; e2 < 4; ++e2) { const float v = a[e2] - o[db][4 * g4 + e2] * li; o[db][4 * g4 + e2] = v; ss += v * v; } }
                ss += __shfl_xor(ss, 32);
                const float rstd = (1.0f - lam_init) / sqrtf(ss * (1.0f / 128.0f) + EPS);
                const float* sg = p.diff_subln_g + e * 128;
                bf16_t* yrow = yb + (size_t)(b * SEQ + qw + r32) * DM + h * 128;
#pragma unroll
                for (int db = 0; db < 4; ++db) {
                    u32x2 wv[4];
#pragma unroll
                    for (int g4 = 0; g4 < 4; ++g4) {
                        const int dv = 32 * db + 8 * g4 + 4 * hi; const f32x4 gv = *(const f32x4*)(sg + dv);
                        wv[g4].x = cvt_pk_bf16(o[db][4 * g4 + 0] * rstd * gv[0], o[db][4 * g4 + 1] * rstd * gv[1]); wv[g4].y = cvt_pk_bf16(o[db][4 * g4 + 2] * rstd * gv[2], o[db][4 * g4 + 3] * rstd * gv[3]);
                    }
#pragma unroll
                    for (int kk = 0; kk < 2; ++kk) *(u32x4*)(yrow + 32 * db + 16 * kk + 8 * hi) = pair_swap(wv[2 * kk], wv[2 * kk + 1]);
                }
            }
        }
    }
#endif
}
__device__ __forceinline__ void attn_win_phase(const Params& p, LAS unsigned char* lds, int layer, int tid, int bx0, int gdim) {
    const int lane = tid & 63, r32 = lane & 31, hi = lane >> 5, wid = tid >> 6;
    const int e = layer >> 1;
    const bf16_t* qkv = (const bf16_t*)(p.ws + WS_R1);
    bf16_t* yb = (bf16_t*)(p.ws + WS_Y);
    const int G = gdim, bx = bx0;
    const int vcu = (G % 8 == 0) ? (bx % 8) * (G / 8) + bx / 8 : bx;
    float mfix;
    { const float* qg = p.qk_norm_g + e * 256 + 128; float ga = fabsf(qg[lane]), gb = fabsf(qg[64 + lane]);
#pragma unroll
      for (int o2 = 1; o2 < 64; o2 <<= 1) { ga = fmaxf(ga, __shfl_xor(ga, o2)); gb = fmaxf(gb, __shfl_xor(gb, o2)); }
      mfix = 0.125f * LOG2E * 64.0f * ga * gb * 1.02f + 1.0f; }
#ifndef NO_WIN
    for (int unit = vcu; unit < 1024; unit += G) {
        const int qb = unit & 7, hq = (unit >> 3) & 7, b = unit >> 6, kvh = hq >> 2;
        build_lut(lds, p.rel_bias, 4 + hq, true, tid);
        const int qw = qb * 256 + wid * 32;
        const bf16_t* qkv_b = qkv + (size_t)b * SEQ * EIN;
        LAS unsigned char* qfp = lds + A_Q_OFF + wid * 4096 + hi * 512 + r32 * 16;
#pragma unroll
        for (int d0 = 0; d0 < 4; ++d0) *(LAS bf16x8*)(qfp + d0 * 1024) = *(const bf16x8*)(qkv_b + (size_t)(qw + r32) * EIN + 1536 + hq * 64 + d0 * 16 + hi * 8);
        f32x16 o[2];
#pragma unroll
        for (int db = 0; db < 2; ++db)
#pragma unroll
            for (int r = 0; r < 16; ++r) o[db][r] = 0.f;
        float m_run = mfix, l_run = 0.5f * ex2(p.sink_logit[e * 8 + hq] * LOG2E - mfix);
        int t0 = (qb * 256 - 128) / 64, t1 = (qb * 256 + 384) / 64; if (qb == 0) t0 = 0; if (t1 > SEQ / 64) t1 = SEQ / 64;
        attn_stream<64, true>(lds, qkv_b + 2048 + kvh * 64, qkv_b + 2176 + kvh * 64, qfp, qw, t0, t1, m_run, l_run, o, tid);
        const float lt = l_run + __shfl_xor(l_run, 32), inv = 1.0f / lt;
        bf16_t* yrow = yb + (size_t)(b * SEQ + qw + r32) * DM + 512 + hq * 64;
#pragma unroll
        for (int db = 0; db < 2; ++db) {
            u32x2 wv[4];
#pragma unroll
            for (int g4 = 0; g4 < 4; ++g4) { wv[g4].x = cvt_pk_bf16(o[db][4 * g4 + 0] * inv, o[db][4 * g4 + 1] * inv); wv[g4].y = cvt_pk_bf16(o[db][4 * g4 + 2] * inv, o[db][4 * g4 + 3] * inv); }
#pragma unroll
            for (int kk = 0; kk < 2; ++kk) *(u32x4*)(yrow + 32 * db + 16 * kk + 8 * hi) = pair_swap(wv[2 * kk], wv[2 * kk + 1]);
        }
    }
#endif
}

constexpr int HC = 32;
constexpr int H_GL = 0, H_QS = H_GL + 32 * 145 * 4, H_KK = H_QS + 32 * 145 * 4, H_QT = H_KK + 32 * 145 * 4, H_KT = H_QT + 32 * 272, H_KH = H_KT + 32 * 272, H_VT = H_KH + 128 * 80,
              H_EGL = H_VT + 2 * 128 * 80, H_LB = H_EGL + 512, H_OP = H_LB + 512, H_END = H_OP + 8 * 1168 * 4;
static_assert(H_END <= LDS_BYTES - 64, "hgrn LDS");
__device__ __forceinline__ int pos16(int x) { return (x & ~12) | ((x & 4) << 1) | ((x & 8) >> 1); }
__device__ __forceinline__ void hgrn_phase(const Params& p, LAS unsigned char* lds, int layer, int tid, int bx, int gdim, bool dummy) {
    const int lane = tid & 63, wid = tid >> 6, r32 = lane & 31, hi = lane >> 5;
    bf16_t* qkv = (bf16_t*)(p.ws + WS_R1);
    LAS float* GL = (LAS float*)(lds + H_GL); LAS float* QS = (LAS float*)(lds + H_QS); LAS float* KK = (LAS float*)(lds + H_KK);
    LAS float* EGL = (LAS float*)(lds + H_EGL); LAS float* LB = (LAS float*)(lds + H_LB); LAS float* OP = (LAS float*)(lds + H_OP);
    for (int unit = bx; unit < 256; unit += gdim) {
        const int b = unit >> 4, h = (unit >> 1) & 7, dir = unit & 1;
        __syncthreads();
        if (tid < 128) {
            const float* cl = p.c_lower_bound + (size_t)dir * 4 * 1024 + h * 128 + tid;
            const float v0 = cl[0], v1 = cl[1024], v2 = cl[2048], v3 = cl[3072];
            const float mx = fmaxf(fmaxf(v0, v1), fmaxf(v2, v3));
            const float e0 = expf(v0 - mx), e1 = expf(v1 - mx), e2 = expf(v2 - mx), e3 = expf(v3 - mx), inv = 1.0f / (e0 + e1 + e2 + e3);
            float lb = 0.f; if (layer >= 1) lb += e1; if (layer >= 2) lb += e2; if (layer >= 3) lb += e3;
            LB[tid] = lb * inv;
        }
        __syncthreads();
        const int li = tid >> 4, ch0 = (tid & 15) * 8;
        const f32x4 lbA = *(const LAS f32x4*)(LB + ch0), lbB = *(const LAS f32x4*)(LB + ch0 + 4);
        bf16_t* base = qkv + (size_t)b * SEQ * OIN + h * 128 + ch0;
        const int fcol = 1024 + dir * 1024;
        const int dvb = wid & 3, dkh = wid >> 2;
        f32x16 S[2];
#pragma unroll
        for (int t = 0; t < 2; ++t)
#pragma unroll
            for (int r = 0; r < 16; ++r) S[t][r] = 0.f;
        u32x4 rq, rf, rv;
        { const int t = dir ? (SEQ - 1 - li) : li; const bf16_t* row = base + (size_t)t * OIN; rq = *(const u32x4*)row; rf = *(const u32x4*)(row + fcol); }
        const int tokv = tid & 31, chv = (tid >> 5) * 8;
        const bf16_t* vbase = qkv + (size_t)b * SEQ * OIN + 3072 + h * 128 + chv;
        { const int t = dir ? (SEQ - 1 - tokv) : tokv; rv = *(const u32x4*)(vbase + (size_t)t * OIN); }
        constexpr int NC = SEQ / HC;
        { const int vsel1 = 0; {
                const unsigned uq[4] = {rq.x, rq.y, rq.z, rq.w}, uf[4] = {rf.x, rf.y, rf.z, rf.w}, uv[4] = {rv.x, rv.y, rv.z, rv.w};
                const int psv = pos16(tokv);
#pragma unroll
                for (int e = 0; e < 8; ++e) {
                    const float q = (e & 1) ? bf_hi(uq[e >> 1]) : bf_lo(uq[e >> 1]), f = (e & 1) ? bf_hi(uf[e >> 1]) : bf_lo(uf[e >> 1]);
                    const float lbv = (e < 4) ? lbA[e & 3] : lbB[e & 3];
                    const float sg = sigm_f(f), sn = 1.0f - sg, fg = lbv + (1.0f - lbv) * sg;
                    GL[li * 145 + ch0 + (ch0 >> 3) + e] = __builtin_amdgcn_logf(fg);
                    QS[li * 145 + ch0 + (ch0 >> 3) + e] = q;
                    KK[li * 145 + ch0 + (ch0 >> 3) + e] = (1.0f - lbv) * sn;
                    const unsigned short vbits = (e & 1) ? (unsigned short)(uv[e >> 1] >> 16) : (unsigned short)(uv[e >> 1] & 0xffffu);
                    *(LAS unsigned short*)(lds + H_VT + vsel1 * (128 * 80) + (chv + e) * 80 + psv * 2) = vbits;
                }
            } }
        __syncthreads();
        { const int cpf = 1; { const int tt = (cpf) * HC + li, t = dir ? (SEQ - 1 - tt) : tt; const bf16_t* row = base + (size_t)t * OIN; rq = *(const u32x4*)row; rf = *(const u32x4*)(row + fcol);  const int ttv = (cpf) * HC + tokv, tv = dir ? (SEQ - 1 - ttv) : ttv; rv = *(const u32x4*)(vbase + (size_t)tv * OIN); } }
        {
                const int d = tid >> 2, tq = tid & 3;
                float G[8]; float run = 0.f;
#pragma unroll
                for (int j = 0; j < 8; ++j) { run += GL[(8 * tq + j) * 145 + d + (d >> 3)]; G[j] = run; }
                const float T0 = __shfl(run, (lane & ~3) + 0), T1 = __shfl(run, (lane & ~3) + 1), T2 = __shfl(run, (lane & ~3) + 2), T3 = __shfl(run, (lane & ~3) + 3);
                const float pre = (tq >= 1 ? T0 : 0.f) + (tq >= 2 ? T1 : 0.f) + (tq >= 3 ? T2 : 0.f), glast = (T0 + T1) + (T2 + T3);
                const int dp = pos16(d);
                const float egl = ex2(glast);
                float kh[8];
#pragma unroll
                for (int j = 0; j < 8; ++j) {
                    const float g = G[j] + pre, eg = ex2(g), ieg = ex2(-g), eh = egl * ieg;
                    const float qv = QS[(8 * tq + j) * 145 + d + (d >> 3)], kv = KK[(8 * tq + j) * 145 + d + (d >> 3)];
                    const unsigned qb = cvt_pk_bf16(qv * eg, 0.f), kb2 = cvt_pk_bf16(kv * ieg, 0.f);
                    *(LAS unsigned short*)(lds + H_QT + (8 * tq + j) * 272 + dp * 2) = (unsigned short)qb;
                    *(LAS unsigned short*)(lds + H_KT + (8 * tq + j) * 272 + dp * 2) = (unsigned short)kb2;
                    kh[j] = kv * eh;
                }
                u32x2 w0, w1; w0.x = cvt_pk_bf16(kh[0], kh[1]); w0.y = cvt_pk_bf16(kh[2], kh[3]); w1.x = cvt_pk_bf16(kh[4], kh[5]); w1.y = cvt_pk_bf16(kh[6], kh[7]);
                const int pb = (tq >> 1) * 16 + 4 * (tq & 1);
                *(LAS u32x2*)(lds + H_KH + d * 80 + pb * 2) = w0; *(LAS u32x2*)(lds + H_KH + d * 80 + (pb + 8) * 2) = w1;
                if (tq == 3) EGL[d] = egl;
            }
        __syncthreads();
        for (int c = 0; c < NC; ++c) {
            { const int vsel3 = c & 1; {
                f32x16 oacc;
#pragma unroll
                for (int r = 0; r < 16; ++r) oacc[r] = 0.f;
#pragma unroll
                for (int t = 0; t < 2; ++t)
#pragma unroll
                    for (int j = 0; j < 2; ++j) {
                        const u32x4 sa = (u32x4){cvt_pk_bf16(S[t][8 * j + 0], S[t][8 * j + 1]), cvt_pk_bf16(S[t][8 * j + 2], S[t][8 * j + 3]), cvt_pk_bf16(S[t][8 * j + 4], S[t][8 * j + 5]), cvt_pk_bf16(S[t][8 * j + 6], S[t][8 * j + 7])};
                        const bf16x8 qb = *(const LAS bf16x8*)(lds + H_QT + r32 * 272 + (32 * (2 * dkh + t) + 16 * j + 8 * hi) * 2);
                        oacc = __builtin_amdgcn_mfma_f32_32x32x16_bf16(__builtin_bit_cast(bf16x8, sa), qb, oacc, 0, 0, 0);
                    }
                if (dkh == 0) {
                    f32x16 at, at2;
#pragma unroll
                    for (int r = 0; r < 16; ++r) { at[r] = 0.f; at2[r] = 0.f; }
#pragma unroll
                    for (int ks = 0; ks < 8; ks += 2) {
                        const bf16x8 ka = *(const LAS bf16x8*)(lds + H_KT + r32 * 272 + (16 * ks + 8 * hi) * 2), qb = *(const LAS bf16x8*)(lds + H_QT + r32 * 272 + (16 * ks + 8 * hi) * 2);
                        const bf16x8 ka2 = *(const LAS bf16x8*)(lds + H_KT + r32 * 272 + (16 * ks + 16 + 8 * hi) * 2), qb2 = *(const LAS bf16x8*)(lds + H_QT + r32 * 272 + (16 * ks + 16 + 8 * hi) * 2);
                        at = __builtin_amdgcn_mfma_f32_32x32x16_bf16(ka, qb, at, 0, 0, 0);
                        at2 = __builtin_amdgcn_mfma_f32_32x32x16_bf16(ka2, qb2, at2, 0, 0, 0);
                    }
                    at += at2;
#pragma unroll
                    for (int r = 0; r < 16; ++r) if (crow(r, hi) > r32) at[r] = 0.f;
                    const u32x4 pw0 = (u32x4){cvt_pk_bf16(at[0], at[1]), cvt_pk_bf16(at[2], at[3]), cvt_pk_bf16(at[4], at[5]), cvt_pk_bf16(at[6], at[7])};
                    const u32x4 pw1 = (u32x4){cvt_pk_bf16(at[8], at[9]), cvt_pk_bf16(at[10], at[11]), cvt_pk_bf16(at[12], at[13]), cvt_pk_bf16(at[14], at[15])};
                    const bf16x8 va0 = *(const LAS bf16x8*)(lds + H_VT + vsel3 * (128 * 80) + (32 * dvb + r32) * 80 + (8 * hi) * 2);
                    const bf16x8 va1 = *(const LAS bf16x8*)(lds + H_VT + vsel3 * (128 * 80) + (32 * dvb + r32) * 80 + (16 + 8 * hi) * 2);
                    oacc = __builtin_amdgcn_mfma_f32_32x32x16_bf16(va0, __builtin_bit_cast(bf16x8, pw0), oacc, 0, 0, 0);
                    oacc = __builtin_amdgcn_mfma_f32_32x32x16_bf16(va1, __builtin_bit_cast(bf16x8, pw1), oacc, 0, 0, 0);
                }
#pragma unroll
                for (int g4 = 0; g4 < 4; ++g4) *(LAS f32x4*)(OP + wid * 1168 + r32 * 36 + 8 * g4 + 4 * hi) = (f32x4){oacc[4 * g4 + 0], oacc[4 * g4 + 1], oacc[4 * g4 + 2], oacc[4 * g4 + 3]};
#pragma unroll
                for (int t = 0; t < 2; ++t) {
                    const int dkb = 2 * dkh + t;
#pragma unroll
                    for (int g4 = 0; g4 < 4; ++g4) { const f32x4 eg = *(const LAS f32x4*)(EGL + 32 * dkb + 8 * g4 + 4 * hi);
#pragma unroll
                        for (int e2 = 0; e2 < 4; ++e2) S[t][4 * g4 + e2] *= eg[e2]; }
#pragma unroll
                    for (int js = 0; js < 2; ++js) {
                        const bf16x8 ka = *(const LAS bf16x8*)(lds + H_KH + (32 * dkb + r32) * 80 + (16 * js + 8 * hi) * 2), vb2 = *(const LAS bf16x8*)(lds + H_VT + vsel3 * (128 * 80) + (32 * dvb + r32) * 80 + (16 * js + 8 * hi) * 2);
                        S[t] = __builtin_amdgcn_mfma_f32_32x32x16_bf16(ka, vb2, S[t], 0, 0, 0);
                    }
                }
            } }
            if (c + 1 < NC) { const int vsel1 = (c + 1) & 1; {
                const unsigned uq[4] = {rq.x, rq.y, rq.z, rq.w}, uf[4] = {rf.x, rf.y, rf.z, rf.w}, uv[4] = {rv.x, rv.y, rv.z, rv.w};
                const int psv = pos16(tokv);
#pragma unroll
                for (int e = 0; e < 8; ++e) {
                    const float q = (e & 1) ? bf_hi(uq[e >> 1]) : bf_lo(uq[e >> 1]), f = (e & 1) ? bf_hi(uf[e >> 1]) : bf_lo(uf[e >> 1]);
                    const float lbv = (e < 4) ? lbA[e & 3] : lbB[e & 3];
                    const float sg = sigm_f(f), sn = 1.0f - sg, fg = lbv + (1.0f - lbv) * sg;
                    GL[li * 145 + ch0 + (ch0 >> 3) + e] = __builtin_amdgcn_logf(fg);
                    QS[li * 145 + ch0 + (ch0 >> 3) + e] = q;
                    KK[li * 145 + ch0 + (ch0 >> 3) + e] = (1.0f - lbv) * sn;
                    const unsigned short vbits = (e & 1) ? (unsigned short)(uv[e >> 1] >> 16) : (unsigned short)(uv[e >> 1] & 0xffffu);
                    *(LAS unsigned short*)(lds + H_VT + vsel1 * (128 * 80) + (chv + e) * 80 + psv * 2) = vbits;
                }
            } }
            __syncthreads();
            { const int cc4 = c; {
                const int ob = ch0 >> 5, dl = ch0 & 31;
                const f32x4 oa0 = *(const LAS f32x4*)(OP + ob * 1168 + li * 36 + dl), oa1 = *(const LAS f32x4*)(OP + ob * 1168 + li * 36 + dl + 4);
                const f32x4 ob0 = *(const LAS f32x4*)(OP + (ob + 4) * 1168 + li * 36 + dl), ob1 = *(const LAS f32x4*)(OP + (ob + 4) * 1168 + li * 36 + dl + 4);
                const f32x4 s0 = oa0 + ob0, s1 = oa1 + ob1;
                const float o8[8] = {s0[0], s0[1], s0[2], s0[3], s1[0], s1[1], s1[2], s1[3]};
                const int tt = cc4 * HC + li, t = dir ? (SEQ - 1 - tt) : tt;
                u32x4 w4; w4.x = cvt_pk_bf16(o8[0], o8[1]); w4.y = cvt_pk_bf16(o8[2], o8[3]); w4.z = cvt_pk_bf16(o8[4], o8[5]); w4.w = cvt_pk_bf16(o8[6], o8[7]);
                if (dummy) *(u32x4*)((bf16_t*)(p.ws + WS_Y) + (size_t)(unit * 32 + li) * 128 + ch0) = w4; else *(u32x4*)(base + (size_t)t * OIN + fcol) = w4;
            } }
            if (c + 2 < NC) { const int cpf = c + 2; { const int tt = (cpf) * HC + li, t = dir ? (SEQ - 1 - tt) : tt; const bf16_t* row = base + (size_t)t * OIN; rq = *(const u32x4*)row; rf = *(const u32x4*)(row + fcol);  const int ttv = (cpf) * HC + tokv, tv = dir ? (SEQ - 1 - ttv) : ttv; rv = *(const u32x4*)(vbase + (size_t)tv * OIN); } }
            if (c + 1 < NC) {
                const int d = tid >> 2, tq = tid & 3;
                float G[8]; float run = 0.f;
#pragma unroll
                for (int j = 0; j < 8; ++j) { run += GL[(8 * tq + j) * 145 + d + (d >> 3)]; G[j] = run; }
                const float T0 = __shfl(run, (lane & ~3) + 0), T1 = __shfl(run, (lane & ~3) + 1), T2 = __shfl(run, (lane & ~3) + 2), T3 = __shfl(run, (lane & ~3) + 3);
                const float pre = (tq >= 1 ? T0 : 0.f) + (tq >= 2 ? T1 : 0.f) + (tq >= 3 ? T2 : 0.f), glast = (T0 + T1) + (T2 + T3);
                const int dp = pos16(d);
                const float egl = ex2(glast);
                float kh[8];
#pragma unroll
                for (int j = 0; j < 8; ++j) {
                    const float g = G[j] + pre, eg = ex2(g), ieg = ex2(-g), eh = egl * ieg;
                    const float qv = QS[(8 * tq + j) * 145 + d + (d >> 3)], kv = KK[(8 * tq + j) * 145 + d + (d >> 3)];
                    const unsigned qb = cvt_pk_bf16(qv * eg, 0.f), kb2 = cvt_pk_bf16(kv * ieg, 0.f);
                    *(LAS unsigned short*)(lds + H_QT + (8 * tq + j) * 272 + dp * 2) = (unsigned short)qb;
                    *(LAS unsigned short*)(lds + H_KT + (8 * tq + j) * 272 + dp * 2) = (unsigned short)kb2;
                    kh[j] = kv * eh;
                }
                u32x2 w0, w1; w0.x = cvt_pk_bf16(kh[0], kh[1]); w0.y = cvt_pk_bf16(kh[2], kh[3]); w1.x = cvt_pk_bf16(kh[4], kh[5]); w1.y = cvt_pk_bf16(kh[6], kh[7]);
                const int pb = (tq >> 1) * 16 + 4 * (tq & 1);
                *(LAS u32x2*)(lds + H_KH + d * 80 + pb * 2) = w0; *(LAS u32x2*)(lds + H_KH + d * 80 + (pb + 8) * 2) = w1;
                if (tq == 3) EGL[d] = egl;
            }
            __syncthreads();
        }
    }
}
__device__ __forceinline__ void hgrn_combine_phase(const Params& p, int layer, int tid, int bx, int gdim) {
    const int lane = tid & 63, wave = tid >> 6;
    const int gw = bx * 8 + wave, ngw = gdim * 8;
    const bf16_t* qkv = (const bf16_t*)(p.ws + WS_R1);
    bf16_t* yb = (bf16_t*)(p.ws + WS_Y);
    const float* og = p.c_out_norm_g + (layer >> 1) * 128;
    for (int m = gw; m < M_TOK; m += ngw) {
        const bf16_t* row = qkv + (size_t)m * OIN;
#pragma unroll
        for (int j = 0; j < 2; ++j) {
            const int ch = j * 512 + lane * 8;
            const u32x4 a = *(const u32x4*)(row + 1024 + ch), bb = *(const u32x4*)(row + 2048 + ch), gg = *(const u32x4*)(row + 4096 + ch);
            float o[8] = {bf_lo(a.x) + bf_lo(bb.x), bf_hi(a.x) + bf_hi(bb.x), bf_lo(a.y) + bf_lo(bb.y), bf_hi(a.y) + bf_hi(bb.y), bf_lo(a.z) + bf_lo(bb.z), bf_hi(a.z) + bf_hi(bb.z), bf_lo(a.w) + bf_lo(bb.w), bf_hi(a.w) + bf_hi(bb.w)};
            const float g[8] = {bf_lo(gg.x), bf_hi(gg.x), bf_lo(gg.y), bf_hi(gg.y), bf_lo(gg.z), bf_hi(gg.z), bf_lo(gg.w), bf_hi(gg.w)};
            float ss = 0.f;
#pragma unroll
            for (int e = 0; e < 8; ++e) ss += o[e] * o[e];
            ss += __shfl_xor(ss, 1); ss += __shfl_xor(ss, 2); ss += __shfl_xor(ss, 4); ss += __shfl_xor(ss, 8);
            const float rstd = 1.0f / sqrtf(ss * (1.0f / 128.0f) + EPS);
            const f32x4 g0 = *(const f32x4*)(og + (ch & 127)), g1 = *(const f32x4*)(og + (ch & 127) + 4);
            u32x4 w;
            w.x = cvt_pk_bf16(o[0] * rstd * g0[0] * silu_f(g[0]), o[1] * rstd * g0[1] * silu_f(g[1])); w.y = cvt_pk_bf16(o[2] * rstd * g0[2] * silu_f(g[2]), o[3] * rstd * g0[3] * silu_f(g[3]));
            w.z = cvt_pk_bf16(o[4] * rstd * g1[0] * silu_f(g[4]), o[5] * rstd * g1[1] * silu_f(g[5])); w.w = cvt_pk_bf16(o[6] * rstd * g1[2] * silu_f(g[6]), o[7] * rstd * g1[3] * silu_f(g[7]));
            *(u32x4*)(yb + (size_t)m * DM + ch) = w;
        }
    }
}

#define XB_TMO      128
#define XB_XCNT(j)  (256  + 64 * (j))
#define XB_XSUB(j)  (1280 + 64 * (j))
#define XB_XGEN(j)  (2304 + 64 * (j))
#define XB_TOP      3328
#define XB_TOPGEN   3392
#define XCD_BAR_WORDS 3456
#define XB_SPIN_CAP (1u << 18)

__device__ __forceinline__ unsigned xb_ld(unsigned* p)              { return __hip_atomic_load(p, __ATOMIC_RELAXED, __HIP_MEMORY_SCOPE_AGENT); }
__device__ __forceinline__ unsigned xb_add(unsigned* p, unsigned v) { return __hip_atomic_fetch_add(p, v, __ATOMIC_RELAXED, __HIP_MEMORY_SCOPE_AGENT); }
__device__ __forceinline__ unsigned xb_xcc_id() { return (unsigned)__builtin_amdgcn_s_getreg((3 << 11) | 20) & 0xFu; }
#define XB_SPIN(cond, bar) do { unsigned _sp = 0; while (cond) { __builtin_amdgcn_s_sleep(1); \
    if ((++_sp & 255u) == 0u) { if (xb_ld(&(bar)[XB_TMO])) break; if (_sp > XB_SPIN_CAP) { atomicAdd(&(bar)[XB_TMO], 1u); break; } } } } while (0)

struct XcdBarrier {
    unsigned* bar; unsigned x;
    volatile LAS unsigned* st;
};

__device__ __forceinline__ XcdBarrier xcd_barrier_post(unsigned* bar, volatile LAS unsigned* st) {
    XcdBarrier b; b.bar = bar; b.x = xb_xcc_id(); b.st = st;
    if (threadIdx.x == 0) (void)xb_add(&bar[XB_XCNT(b.x)], 1u);
    return b;
}
__device__ __forceinline__ void xcd_barrier_complete(unsigned* bar, unsigned x, unsigned& nloc, unsigned& nx) {
    const unsigned G = gridDim.x * gridDim.y * gridDim.z;
    unsigned sum, cnt, mine, sp = 0u;
    for (;;) {
        sum = 0u; cnt = 0u; mine = 0u;
#pragma unroll
        for (unsigned j = 0; j < 16; ++j) { const unsigned c = xb_ld(&bar[XB_XCNT(j)]); sum += c; cnt += (c > 0u) ? 1u : 0u; mine = (j == x) ? c : mine; }
        if (sum == G) break;
        __builtin_amdgcn_s_sleep(1);
        if ((++sp & 255u) == 0u) { if (xb_ld(&bar[XB_TMO])) break; if (sp > XB_SPIN_CAP) { atomicAdd(&bar[XB_TMO], 1u); break; } }
    }
    nloc = mine > 0u ? mine : 1u; nx = cnt > 0u ? cnt : 1u;
}

__device__ __forceinline__ void xcd_barrier(const XcdBarrier& b) {
    asm volatile("s_waitcnt vmcnt(0)" ::: "memory");
    __syncthreads();
    if (threadIdx.x == 0) {
        unsigned* bar = b.bar;
        __builtin_amdgcn_s_waitcnt(0);
        unsigned nloc = b.st[0], nx = b.st[1];
        if (nloc == 0u) { xcd_barrier_complete(bar, b.x, nloc, nx); b.st[0] = nloc; b.st[1] = nx; }
        const unsigned old = xb_add(&bar[XB_XSUB(b.x)], 1u);
        const unsigned gen = old / nloc;
        if (old + 1u == (gen + 1u) * nloc) {
            __builtin_amdgcn_fence(__ATOMIC_RELEASE, "agent");
            asm volatile("s_waitcnt vmcnt(0)" ::: "memory");
            const unsigned og = xb_add(&bar[XB_TOP], 1u);
            const unsigned tg = og / nx;
            if (og + 1u == (tg + 1u) * nx) xb_add(&bar[XB_TOPGEN], 1u);
            else XB_SPIN(xb_ld(&bar[XB_TOPGEN]) == tg, bar);
            __builtin_amdgcn_fence(__ATOMIC_ACQUIRE, "agent");
            xb_add(&bar[XB_XGEN(b.x)], 1u);
            asm volatile("s_waitcnt vmcnt(0)" ::: "memory");
        } else {
            XB_SPIN(xb_ld(&bar[XB_XGEN(b.x)]) == gen, bar);
            __builtin_amdgcn_fence(__ATOMIC_ACQUIRE, "agent");
            asm volatile("s_waitcnt vmcnt(0)" ::: "memory");
        }
    }
    __syncthreads();
}

__global__ void __launch_bounds__(512) mega_fwd(Params p) {
    extern __shared__ __attribute__((aligned(16))) unsigned char lds_raw[];
    LAS unsigned char* lds = (LAS unsigned char*)lds_raw;
    cg::grid_group grid = cg::this_grid();
    volatile LAS unsigned* bst = (volatile LAS unsigned*)(lds + LDS_BYTES - 64);
    if (threadIdx.x < 4) bst[threadIdx.x] = 0u;
    __syncthreads();
    (void)xcd_barrier_post((unsigned*)(p.ws + WS_BAR), bst);
#define HB ((bf16_t*)(p.ws + WS_H))
#define YB ((bf16_t*)(p.ws + WS_Y))
#define R1 ((bf16_t*)(p.ws + WS_R1))
    int prep_cnt = 0;
#pragma unroll 1
    for (int ph = p.ph_lo; ph < p.ph_hi; ++ph) {
        if (ph > 0 && (((ph - 1) / 11) & 1) == 0 && (ph - 1) % 11 == 5) continue;
        int tid = threadIdx.x, bx = blockIdx.x; asm volatile("" : "+v"(tid)); asm volatile("" : "+s"(bx)); int gdim = gridDim.x; asm volatile("" : "+s"(gdim));
        typedef const __attribute__((address_space(4))) Params* kparg_t;
        kparg_t kq = (kparg_t)__builtin_amdgcn_kernarg_segment_ptr(); asm volatile("" : "+s"(kq));
        Params P;
#if defined(__HIP_DEVICE_COMPILE__)
        P = *kq;
#else
        P = p;
#endif
        if (ph > p.ph_lo) { if (p.ph_lo < 0) grid.sync(); else { XcdBarrier xbar; xbar.bar = (unsigned*)(P.ws + WS_BAR); xbar.x = xb_xcc_id(); xbar.st = (volatile LAS unsigned*)(lds + LDS_BYTES - 64);
            for (int rep = 0; rep < PROBE_SYNC_REP; ++rep) xcd_barrier(xbar); } }
        if (ph == 0) {
#ifndef NO_PREP
            for (int rep = 0; rep < PROBE_PREP_REP; ++rep) prep_phase(P, lds, tid, bx, gdim);
#endif
            continue; }
        const int l = (ph - 1) / 11, s = (ph - 1) % 11;
        const float* modl = (const float*)(P.ws + WS_MOD) + (size_t)l * 16 * NMOD;
        if (s == 0 || s == 3 || s == 8) {
            const int j = (s == 0) ? 0 : (s == 3 ? 1 : 2);
            const float* xin = (l == 0 && s == 0) ? P.x : P.out;
            for (int rep = 0; rep < PROBE_NORM_REP; ++rep) norm_phase(xin, P.norm_g + (size_t)(l * 3 + j) * DM, modl, 3 * j, HB, tid, bx, gdim);
        } else if (s == 1 || s == 9 || s == 2 || s == 10 || s == 7 || s == 4) {
            pg8::Gemm g; EpiMulti E; E.O = R1; E.ldc = FF; E.base = P.out; E.out = P.out; E.gate = modl; E.coef = 1.0f; E.presilu = 0;
            if (s == 1 || s == 9) {
                const int fi = (s == 1) ? 0 : 1;
                g = pg8::Gemm{HB, (const bf16_t*)(P.ws + WS_WUP) + (size_t)(l * 2 + fi) * NUP * DM, M_TOK, NUP, DM}; E.mode = 0;
            } else if (s == 7) {
                const bf16_t* w = (l & 1) ? (const bf16_t*)(P.ws + WS_WOOUT) + (size_t)(l >> 1) * DM * DM : (const bf16_t*)(P.ws + WS_WEOUT) + (size_t)(l >> 1) * DM * DM;
                g = pg8::Gemm{YB, w, M_TOK, DM, DM}; E.mode = 1; E.gate = modl + 5 * 1024; E.coef = 1.0f;
            } else if (s == 4) {
                const int N = (l & 1) ? OIN : EIN;
                const bf16_t* w = (l & 1) ? (const bf16_t*)(P.ws + WS_WOIN) + (size_t)(l >> 1) * OIN * DM : (const bf16_t*)(P.ws + WS_WEIN) + (size_t)(l >> 1) * EIN * DM;
                g = pg8::Gemm{HB, w, M_TOK, N, DM}; E.mode = (l & 1) ? 2 : 3; E.presilu = (l & 1); E.ldc = N; E.gate = P.qk_norm_g + (size_t)(l >> 1) * 256;
            } else {
                const int fi = (s == 2) ? 0 : 1;
                g = pg8::Gemm{R1, (const bf16_t*)(P.ws + WS_WDN) + (size_t)(l * 2 + fi) * DM * FF, M_TOK, DM, FF}; E.mode = 1; E.gate = modl + (fi ? 8 : 2) * 1024; E.coef = 0.5f;
                if (l == 0 && s == 2) E.base = P.x;
            }
            if (PROBE_DOWN_REP > 1 && (s == 2 || s == 10) && prep_cnt + 1 < PROBE_DOWN_REP) E.out = (float*)(P.ws + WS_H);
            if (PROBE_OUT_REP > 1 && s == 7 && prep_cnt + 1 < PROBE_OUT_REP) E.out = (float*)(P.ws + WS_R1);
            pg8::StaticOrder S; S.init(g.M, g.N, gdim, bx);
#ifndef NO_G1
            pg8::gemm_phase<EpiMulti, pg8::StaticOrder, false>(lds, g, S, E, nullptr, tid);
            if (PROBE_UP_REP > 1 && (s == 1 || s == 9)) { if (prep_cnt + 1 < PROBE_UP_REP) { ++prep_cnt; --ph; } else prep_cnt = 0; }
            if (PROBE_DOWN_REP > 1 && (s == 2 || s == 10)) { if (prep_cnt + 1 < PROBE_DOWN_REP) { ++prep_cnt; --ph; } else prep_cnt = 0; }
            if (PROBE_OUT_REP > 1 && s == 7) { if (prep_cnt + 1 < PROBE_OUT_REP) { ++prep_cnt; --ph; } else prep_cnt = 0; }
            if (PROBE_IN_REP > 1 && s == 4) { if (prep_cnt + 1 < PROBE_IN_REP) { ++prep_cnt; --ph; } else prep_cnt = 0; }
#endif
        } else if (s == 5) {
            if (l & 1) {
#ifndef NO_HGRN
                for (int rep = 0; rep < PROBE_HGRN_REP; ++rep) hgrn_phase(P, lds, l, tid, bx, gdim, rep + 1 < PROBE_HGRN_REP);
#endif
            } else {
#ifndef NO_QKN
                qknorm_phase(R1, P.qk_norm_g + (size_t)(l >> 1) * 256, tid, bx, gdim);
#endif
            }
        } else {
            if (l & 1) {
#ifndef NO_COMB
                hgrn_combine_phase(P, l, tid, bx, gdim);
#endif
            } else {
#ifndef NO_ATTN
                for (int rep = 0; rep < PROBE_ATT_REP; ++rep) {
                attn_phase(P, lds, l, tid, bx, gdim);
                { int tid2 = tid; asm volatile("" : "+v"(tid2)); attn_win_phase(P, lds, l, tid2, bx, gdim); }
                }
#endif
            }
        }
    }
#undef HB
#undef YB
#undef R1
}

#ifndef MK_PER_PHASE
#define MK_PER_PHASE 0
#endif
extern "C" void kernel_launch(void* const* d_in, const int* in_sizes, int n_in, void* d_out, int out_size, void* d_ws, size_t ws_size, hipStream_t stream) {
    static int grid = 0;
    if (grid == 0) {
        if (n_in != 18 || out_size != M_TOK * DM || ws_size < WS_END) { fprintf(stderr, "kernel_launch: unexpected shapes (n_in %d out %d ws %zu need %zu)\n", n_in, out_size, ws_size, (size_t)WS_END); grid = -1; return; }
        int dev = 0, cus = 0, per_cu = 0;
        hipGetDevice(&dev);
        hipDeviceGetAttribute(&cus, hipDeviceAttributeMultiprocessorCount, dev);
        if (hipFuncSetAttribute((const void*)mega_fwd, hipFuncAttributeMaxDynamicSharedMemorySize, LDS_BYTES) != hipSuccess) { fprintf(stderr, "kernel_launch: hipFuncSetAttribute failed\n"); grid = -1; return; }
        if (hipOccupancyMaxActiveBlocksPerMultiprocessor(&per_cu, (const void*)mega_fwd, 512, LDS_BYTES) != hipSuccess || per_cu < 1) { fprintf(stderr, "kernel_launch: occupancy query says %d\n", per_cu); per_cu = 1; }
        (void)hipGetLastError();
        grid = cus * 1;
    }
    if (grid < 0) return;
    Params p{};
    const float** pp = (const float**)&p;
    for (int i = 0; i < 18; ++i) pp[i] = (const float*)d_in[i];
    p.out = (float*)d_out; p.ws = (unsigned char*)d_ws;
#if MK_PER_PHASE
    for (int ph = 0; ph < N_PHASES; ++ph) {
        p.ph_lo = ph; p.ph_hi = ph + 1;
        hipLaunchKernelGGL(mega_fwd, dim3(grid), dim3(512), LDS_BYTES, stream, p);
    }
#else
    p.ph_lo = 0; p.ph_hi = N_PHASES;
    if (hipMemsetAsync((unsigned char*)d_ws + WS_BAR, 0, 16384, stream) != hipSuccess) { fprintf(stderr, "kernel_launch: memset of barrier words failed\n"); return; }
    void* args[] = {&p};
    hipError_t e = hipLaunchCooperativeKernel((const void*)mega_fwd, dim3(grid), dim3(512), args, LDS_BYTES, stream);
    if (e != hipSuccess) fprintf(stderr, "cooperative launch failed: %s (grid %d)\n", hipGetErrorString(e), grid);
#endif
}
```

```cpp
#include <hip/hip_runtime.h>
#include <hip/hip_cooperative_groups.h>
#include <cstdio>
namespace cg = cooperative_groups;
namespace pg8 {
#define PG8_LAS __attribute__((address_space(3)))
typedef unsigned short bf16_t;
typedef short bf16x8 __attribute__((ext_vector_type(8)));
typedef float f32x4 __attribute__((ext_vector_type(4)));
typedef unsigned u32x4 __attribute__((ext_vector_type(4)));
constexpr int BM = 256, BK = 64, HALF = 128, HTB = HALF * BK * 2  , STAGE_BYTES = 8 * HTB, NXCD = 8, WGM = 8;

__host__ __device__ __forceinline__ int lds_byte(int r, int c) { const int st = (r >> 4) * 2 + (c >> 5), rr = r & 15, cc = c & 31, ob = rr * 64 + cc * 2; return st * 1024 + (ob ^ (((ob >> 9) & 1) << 5)); }
__host__ __device__ __forceinline__ void stage_rc(int b, int& R, int& C) { const int st = b / 1024, sb = b % 1024, swz = sb ^ (((sb >> 9) & 1) << 5); R = (st >> 1) * 16 + swz / 64; C = (st & 1) * 32 + (swz % 64) / 2; }
__host__ __device__ __forceinline__ int perm32(int rho) { const int n = rho >> 4, i = rho & 15; return 8 * (i >> 2) + 4 * n + (i & 3); }

struct Unit { int pm, pn; };
struct Gemm { const bf16_t* A; const bf16_t* Bt; int M, N, K; };

struct StaticOrder {
    int nM, nN, nwg, G, c;
    __host__ __device__ void init(int M, int N, int G_, int c_) { nM = M / BM; nN = N / BM; nwg = nM * nN; G = G_; c = c_; }
    __host__ __device__ bool next(int i, Unit& u) const {
        const long L = (long)i * G + c; if (L >= nwg) return false;
        int wgid = (int)L; { const int q = nwg / NXCD, r = nwg % NXCD, xcd = wgid % NXCD, off = wgid / NXCD; wgid = (xcd < r ? xcd * (q + 1) : r * (q + 1) + (xcd - r) * q) + off; }
        const int nig = WGM * nN, gid = wgid / nig, fm = gid * WGM, gsz = (nM - fm) < WGM ? (nM - fm) : WGM;
        u.pm = fm + ((wgid % nig) % gsz); u.pn = (wgid % nig) / gsz; return true;
    }
    __device__ __forceinline__ void a_ready(const Unit&) const {}
    __device__ __forceinline__ void done(const Unit&) const {}
};
__device__ __forceinline__ unsigned cvt_pk_bf16(float lo, float hi) { unsigned r; asm volatile("v_cvt_pk_bf16_f32 %0, %1, %2" : "=v"(r) : "v"(lo), "v"(hi)); return r; }
typedef float f32x2 __attribute__((ext_vector_type(2)));
template <class Epi, class Sched, bool STAMP = false>
__device__ __forceinline__ void gemm_phase(PG8_LAS unsigned char* lds, const Gemm g, const Sched& S, const Epi& E, unsigned long long* stamps, const int tid) {
    const int wid = __builtin_amdgcn_readfirstlane(tid >> 6), lane = tid & 63, wr = wid >> 2, wc = wid & 3, fr = lane & 15, fq = lane >> 4;
    const int K = g.K, nt = K / BK;
    int ts_lo = 0, ts_hi = 0, nts = 0; const unsigned long long rt_entry = STAMP ? (unsigned long long)wall_clock64() : 0ull;
#define PG8_STAMP() do { if (STAMP && wid == 0 && nts < 64) { const unsigned long long _c = (unsigned long long)clock64(); \
        ts_lo = (lane == nts) ? (int)(unsigned)_c : ts_lo; ts_hi = (lane == nts) ? (int)(unsigned)(_c >> 32) : ts_hi; ++nts; } } while (0)
    PG8_STAMP();
    unsigned voffA[2], voffB[2];
#pragma unroll
    for (int i = 0; i < 2; ++i) { int R, C; stage_rc(tid * 16 + i * 8192, R, C); const int Rb = Epi::PERM ? ((R & ~31) + perm32(R & 31)) : R;
        voffA[i] = (unsigned)(R * K + C) * 2u; voffB[i] = (unsigned)(Rb * K + C) * 2u; }
    const size_t kstep = (size_t)(BK * 2);
    const size_t hstep = (size_t)HALF * K * 2;
    const size_t tstep = 2 * hstep;
    const unsigned ldsw = (unsigned)wid * 1024u;
    const int aoff = lds_byte(wr * 64 + fr, fq * 8), boff = lds_byte(wc * 32 + fr, fq * 8);
#define PG8_SA(b, h) (((b) * 2 + (h)) * HTB)
#define PG8_SB(b, h) ((4 + (b) * 2 + (h)) * HTB)
#define PG8_STAGE(bufoff, gbase, voff) do { _Pragma("unroll") for (int _i = 0; _i < 2; ++_i) \
        __builtin_amdgcn_global_load_lds((const unsigned*)((const char*)(gbase) + (voff)[_i]), (PG8_LAS unsigned*)(lds + (bufoff) + ldsw + _i * 8192), 16, 0, 0); } while (0)
#define PG8_LDA(dst, b, h) do { _Pragma("unroll") for (int m = 0; m < 4; ++m) _Pragma("unroll") for (int k = 0; k < 2; ++k) dst[m][k] = *(const PG8_LAS bf16x8*)(lds + PG8_SA(b, h) + aoff + m * 2048 + k * 1024); } while (0)
#define PG8_LDB(dst, b, h) do { _Pragma("unroll") for (int n = 0; n < 2; ++n) _Pragma("unroll") for (int k = 0; k < 2; ++k) dst[n][k] = *(const PG8_LAS bf16x8*)(lds + PG8_SB(b, h) + boff + n * 2048 + k * 1024); } while (0)
#define PG8_MMA(ai, bj, At, Bt) do { __builtin_amdgcn_s_setprio(1); _Pragma("unroll") for (int m = 0; m < 4; ++m) _Pragma("unroll") for (int n = 0; n < 2; ++n) _Pragma("unroll") for (int k = 0; k < 2; ++k) \
        acc[ai][bj][m][n] = __builtin_amdgcn_mfma_f32_16x16x32_bf16(Bt[n][k], At[m][k], acc[ai][bj][m][n], 0, 0, 0); __builtin_amdgcn_s_setprio(0); } while (0)
#define PG8_WAIT_V(n) asm volatile("s_waitcnt vmcnt(" #n ")" ::: "memory")
#define PG8_WAIT_L(n) asm volatile("s_waitcnt lgkmcnt(" #n ")" ::: "memory")
#define PG8_BAR __builtin_amdgcn_s_barrier()
#define PG8_SCHED __builtin_amdgcn_sched_barrier(0)
    Unit cur, nxt; int ui = 0;
    if (!S.next(0, cur)) return;
    f32x4 acc[2][2][4][2];
#pragma unroll
    for (int a = 0; a < 2; ++a)
#pragma unroll
        for (int b = 0; b < 2; ++b)
#pragma unroll
            for (int m = 0; m < 4; ++m)
#pragma unroll
                for (int n = 0; n < 2; ++n) acc[a][b][m][n] = (f32x4){0.f, 0.f, 0.f, 0.f};
    bf16x8 At[4][2], B0[2][2], B1[2][2];
    const char* cA = (const char*)g.A + (size_t)cur.pm * tstep; const char* cB = (const char*)g.Bt + (size_t)cur.pn * tstep;
    S.a_ready(cur);
    PG8_STAGE(PG8_SB(0, 0), cB, voffB); PG8_STAGE(PG8_SA(0, 0), cA, voffA); PG8_STAGE(PG8_SB(0, 1), cB + hstep, voffB); PG8_STAGE(PG8_SA(0, 1), cA + hstep, voffA);
    if (wr == 1) PG8_BAR;
    PG8_WAIT_V(4); PG8_BAR;
    PG8_STAGE(PG8_SB(1, 0), cB + kstep, voffB); PG8_STAGE(PG8_SA(1, 0), cA + kstep, voffA); PG8_STAGE(PG8_SB(1, 1), cB + hstep + kstep, voffB);
    PG8_WAIT_V(6); PG8_BAR;
    PG8_STAMP();
    for (;;) {
        const bool has_next = S.next(ui + 1, nxt);
        const char* nA = has_next ? (const char*)g.A + (size_t)nxt.pm * tstep : cA; const char* nB = has_next ? (const char*)g.Bt + (size_t)nxt.pn * tstep : cB;
        for (int t = 0; t < nt; t += 2) {
            const bool last = (t == nt - 2);
            const bool tail = last && !has_next;
            const char* a1 = cA + (size_t)(t + 1) * kstep;
            const char* a2 = last ? nA : cA + (size_t)(t + 2) * kstep; const char* b2 = last ? nB : cB + (size_t)(t + 2) * kstep;
            const char* a3 = a2 + kstep; const char* b3 = b2 + kstep;
            if (last && has_next) S.a_ready(nxt);
            PG8_LDB(B0, 0, 0); PG8_SCHED; PG8_LDA(At, 0, 0); PG8_STAGE(PG8_SA(1, 1), a1 + hstep, voffA);
            PG8_WAIT_L(8); PG8_BAR; PG8_WAIT_L(0); PG8_MMA(0, 0, At, B0); PG8_BAR; PG8_SCHED;
            PG8_LDB(B1, 0, 1); if (!tail) PG8_STAGE(PG8_SB(0, 0), b2, voffB);
            PG8_BAR; PG8_WAIT_L(0); PG8_MMA(0, 1, At, B1); PG8_BAR;
            PG8_LDA(At, 0, 1); if (!tail) PG8_STAGE(PG8_SA(0, 0), a2, voffA);
            PG8_BAR; PG8_WAIT_L(0); PG8_MMA(1, 0, At, B0); PG8_BAR; PG8_SCHED;
            if (!tail) PG8_STAGE(PG8_SB(0, 1), b2 + hstep, voffB);
            if (tail) { PG8_WAIT_V(0); } else { PG8_WAIT_V(6); } PG8_BAR; PG8_MMA(1, 1, At, B1); PG8_BAR;
            PG8_LDB(B0, 1, 0); PG8_SCHED; PG8_LDA(At, 1, 0); if (!tail) PG8_STAGE(PG8_SA(0, 1), a2 + hstep, voffA);
            PG8_WAIT_L(8); PG8_BAR; PG8_WAIT_L(0); PG8_MMA(0, 0, At, B0); PG8_BAR; PG8_SCHED;
            PG8_LDB(B1, 1, 1); if (!tail) PG8_STAGE(PG8_SB(1, 0), b3, voffB);
            PG8_BAR; PG8_WAIT_L(0); PG8_MMA(0, 1, At, B1); PG8_BAR;
            PG8_LDA(At, 1, 1); if (!tail) PG8_STAGE(PG8_SA(1, 0), a3, voffA);
            PG8_BAR; PG8_WAIT_L(0); PG8_MMA(1, 0, At, B0); PG8_BAR; PG8_SCHED;
            if (!tail) PG8_STAGE(PG8_SB(1, 1), b3 + hstep, voffB);
            if (tail) { PG8_WAIT_V(0); } else { PG8_WAIT_V(6); } PG8_BAR; PG8_MMA(1, 1, At, B1); PG8_BAR;
        }
        PG8_STAMP();
        if constexpr (!Epi::AFTER_DRAIN) { E(acc, cur, wr, wc, fr, fq); S.done(cur); }
        PG8_STAMP();
        if (!has_next) break;
#pragma unroll
        for (int a = 0; a < 2; ++a)
#pragma unroll
            for (int b = 0; b < 2; ++b)
#pragma unroll
                for (int m = 0; m < 4; ++m)
#pragma unroll
                    for (int n = 0; n < 2; ++n) acc[a][b][m][n] = (f32x4){0.f, 0.f, 0.f, 0.f};
        cur = nxt; cA = nA; cB = nB; ++ui;
    }
    PG8_WAIT_V(0);
    if (wr == 0) PG8_BAR;
    PG8_BAR;
    if constexpr (Epi::AFTER_DRAIN) { E.fused(acc, cur, wr, wc, fr, fq, lds, wid, lane); S.done(cur); }
    PG8_STAMP();
    if (STAMP && wid == 0) { stamps[lane] = lane < nts ? (((unsigned long long)(unsigned)ts_hi << 32) | (unsigned)ts_lo) : 0ull;
        if (lane == 62) stamps[62] = rt_entry; if (lane == 63) stamps[63] = (unsigned long long)wall_clock64(); }
#undef PG8_STAMP
#undef PG8_SA
#undef PG8_SB
#undef PG8_STAGE
#undef PG8_LDA
#undef PG8_LDB
#undef PG8_MMA
#undef PG8_WAIT_V
#undef PG8_WAIT_L
#undef PG8_BAR
#undef PG8_SCHED
}
}

#define LAS __attribute__((address_space(3)))
using pg8::bf16_t; using pg8::bf16x8; using pg8::f32x4; using pg8::u32x4; using pg8::cvt_pk_bf16;
typedef short s16x4 __attribute__((ext_vector_type(4)));
typedef float f32x2 __attribute__((ext_vector_type(2)));
typedef float f32x16 __attribute__((ext_vector_type(16)));
typedef unsigned u32x2 __attribute__((ext_vector_type(2)));

constexpr int M_TOK = 32768, DM = 1024, SEQ = 2048, FF = 2816, NUP = 5632, EIN = 2304, OIN = 5120, NMOD = 9216;
constexpr float EPS = 1e-6f, LOG2E = 1.4426950408889634f;
constexpr int LDS_BYTES = 147456;
constexpr int N_PHASES = 45;
#ifndef PROBE_ATT_REP
#define PROBE_ATT_REP 1
#endif
#ifndef PROBE_HGRN_REP
#define PROBE_HGRN_REP 1
#endif
#ifndef PROBE_UP_REP
#define PROBE_UP_REP 1
#endif
#ifndef PROBE_PREP_REP
#define PROBE_PREP_REP 1
#endif
#ifndef PROBE_SYNC_REP
#define PROBE_SYNC_REP 1
#endif
#ifndef PROBE_DOWN_REP
#define PROBE_DOWN_REP 1
#endif
#ifndef PROBE_OUT_REP
#define PROBE_OUT_REP 1
#endif
#ifndef PROBE_IN_REP
#define PROBE_IN_REP 1
#endif
#ifndef PROBE_NORM_REP
#define PROBE_NORM_REP 1
#endif

constexpr size_t al256(size_t x) { return (x + 255) & ~(size_t)255; }
constexpr size_t WS_MOD = 0;
constexpr size_t WS_WUP = al256(WS_MOD + 4ull * 16 * NMOD * 4);
constexpr size_t WS_WDN = WS_WUP + 8ull * NUP * DM * 2;
constexpr size_t WS_WEIN = WS_WDN + 8ull * DM * FF * 2;
constexpr size_t WS_WEOUT = WS_WEIN + 2ull * EIN * DM * 2;
constexpr size_t WS_WOIN = WS_WEOUT + 2ull * DM * DM * 2;
constexpr size_t WS_WOOUT = WS_WOIN + 2ull * OIN * DM * 2;
constexpr size_t WS_H = WS_WOOUT + 2ull * DM * DM * 2;
constexpr size_t WS_Y = WS_H + (size_t)M_TOK * DM * 2;
constexpr size_t WS_R1 = WS_Y + (size_t)M_TOK * DM * 2;
constexpr size_t WS_O1 = WS_R1 + (size_t)M_TOK * OIN * 2;
constexpr size_t WS_BAR = WS_O1 + 512ull * 8 * 16 * 64 * 16;
constexpr size_t WS_END = WS_BAR + 16384;

struct Params {
    const float *x, *c, *ada_w, *ada_b, *norm_g, *ffn_up, *ffn_down, *even_w_in, *even_w_out, *qk_norm_g, *diff_lambda, *diff_subln_g, *sink_logit, *rel_bias,
        *odd_w_in, *odd_w_out, *c_lower_bound, *c_out_norm_g;
    float* out; unsigned char* ws; int ph_lo, ph_hi;
};

__device__ __forceinline__ float bf_lo(unsigned u) { return __uint_as_float(u << 16); }
__device__ __forceinline__ float bf_hi(unsigned u) { return __uint_as_float(u & 0xffff0000u); }
__device__ __forceinline__ float wave_sum(float v) {
#pragma unroll
    for (int o = 1; o < 64; o <<= 1) v += __shfl_xor(v, o);
    return v;
}
__device__ __forceinline__ float ex2(float v) { return __builtin_amdgcn_exp2f(v); }
__device__ __forceinline__ float silu_f(float a) { return a * __builtin_amdgcn_rcpf(1.f + ex2(-a * LOG2E)); }
__device__ __forceinline__ float sigm_f(float a) { return __builtin_amdgcn_rcpf(1.f + ex2(-a * LOG2E)); }

__device__ __forceinline__ unsigned swiglu_pk(f32x2 a, f32x2 b) {
    const f32x2 t = a * (-LOG2E);
    f32x2 e; e.x = ex2(t.x); e.y = ex2(t.y);
    const f32x2 d = e + 1.0f;
    f32x2 r; r.x = __builtin_amdgcn_rcpf(d.x); r.y = __builtin_amdgcn_rcpf(d.y);
    const f32x2 o = (a * b) * r;
    return cvt_pk_bf16(o.x, o.y);
}
struct EpiMulti {
    static constexpr bool PERM = true, AFTER_DRAIN = false;
    int mode; bf16_t* O; int ldc; const float* base; float* out; const float* gate; float coef; int presilu;
    __device__ __forceinline__ void operator()(const f32x4 (&acc)[2][2][4][2], const pg8::Unit& u, int wr, int wc, int fr, int fq) const {
        const int row0 = u.pm * 256 + wr * 64 + fr;
        if (mode == 0) {
            const int col0 = u.pn * 128 + wc * 32 + 8 * fq;
#pragma unroll
            for (int ai = 0; ai < 2; ++ai)
#pragma unroll
                for (int m = 0; m < 4; ++m) {
                    bf16_t* rowp = O + (size_t)(row0 + ai * 128 + m * 16) * FF + col0;
                    const f32x4 a0 = acc[ai][0][m][0], a1 = acc[ai][0][m][1], b0 = acc[ai][1][m][0], b1 = acc[ai][1][m][1];
                    u32x4 w;
                    w.x = swiglu_pk((f32x2){a0[0], a0[1]}, (f32x2){b0[0], b0[1]}); w.y = swiglu_pk((f32x2){a0[2], a0[3]}, (f32x2){b0[2], b0[3]});
                    w.z = swiglu_pk((f32x2){a1[0], a1[1]}, (f32x2){b1[0], b1[1]}); w.w = swiglu_pk((f32x2){a1[2], a1[3]}, (f32x2){b1[2], b1[3]});
                    *(u32x4*)rowp = w;
                    asm volatile("" ::: "memory");
                }
        } else if (mode == 1) {
            const int col0 = u.pn * 256 + wc * 32 + 8 * fq, b = u.pm >> 3;
#pragma unroll
            for (int bj = 0; bj < 2; ++bj) {
                const f32x4 g0 = *(const f32x4*)(gate + (size_t)b * NMOD + col0 + bj * 128) * coef, g1 = *(const f32x4*)(gate + (size_t)b * NMOD + col0 + bj * 128 + 4) * coef;
                const unsigned rb = (unsigned)row0 * DM + (unsigned)(col0 + bj * 128);
#pragma unroll
                for (int ai = 0; ai < 2; ++ai) {
                    f32x4 bs[4][2];
#pragma unroll
                    for (int m = 0; m < 4; ++m) {
                        const unsigned off = rb + (unsigned)((ai * 128 + m * 16) * DM);
                        bs[m][0] = *(const f32x4*)(base + off); bs[m][1] = *(const f32x4*)(base + off + 4);
                    }
#pragma unroll
                    for (int m = 0; m < 4; ++m) {
                        const unsigned off = rb + (unsigned)((ai * 128 + m * 16) * DM);
                        *(f32x4*)(out + off) = bs[m][0] + g0 * acc[ai][bj][m][0];
                        *(f32x4*)(out + off + 4) = bs[m][1] + g1 * acc[ai][bj][m][1];
                    }
                    asm volatile("" ::: "memory");
                }
            }
        } else if (mode == 3) {
            const int head = u.pn * 4 + wc;
            const int set = head < 8 ? 0 : head < 16 ? 1 : head < 24 ? -1 : head < 32 ? 2 : head < 34 ? 3 : -1;
            bf16_t* obase = O + head * 64 + 8 * fq;
            if (set >= 0) {
                const float qs = (set == 0 || set == 2) ? 0.125f * LOG2E : 1.0f;
                f32x4 gq[2][2];
#pragma unroll
                for (int bj = 0; bj < 2; ++bj)
#pragma unroll
                    for (int n = 0; n < 2; ++n) gq[bj][n] = *(const f32x4*)(gate + set * 64 + bj * 32 + 8 * fq + 4 * n);
#pragma unroll
                for (int ai = 0; ai < 2; ++ai)
#pragma unroll
                    for (int m = 0; m < 4; ++m) {
                        float ss = 0.f;
#pragma unroll
                        for (int bj = 0; bj < 2; ++bj)
#pragma unroll
                            for (int n = 0; n < 2; ++n) { const f32x4 v = acc[ai][bj][m][n]; ss += (v[0] * v[0] + v[1] * v[1]) + (v[2] * v[2] + v[3] * v[3]); }
                        ss += __shfl_xor(ss, 16); ss += __shfl_xor(ss, 32);
                        const float rstd = qs / sqrtf(ss * (1.0f / 64.0f) + EPS);
                        bf16_t* rowp = obase + (size_t)(row0 + ai * 128 + m * 16) * EIN;
#pragma unroll
                        for (int bj = 0; bj < 2; ++bj) {
                            const f32x4 v0 = acc[ai][bj][m][0] * rstd * gq[bj][0], v1 = acc[ai][bj][m][1] * rstd * gq[bj][1];
                            u32x4 w; w.x = cvt_pk_bf16(v0[0], v0[1]); w.y = cvt_pk_bf16(v0[2], v0[3]); w.z = cvt_pk_bf16(v1[0], v1[1]); w.w = cvt_pk_bf16(v1[2], v1[3]);
                            *(u32x4*)(rowp + bj * 32) = w;
                        }
                    }
            } else {
#pragma unroll
                for (int ai = 0; ai < 2; ++ai)
#pragma unroll
                    for (int m = 0; m < 4; ++m) {
                        bf16_t* rowp = obase + (size_t)(row0 + ai * 128 + m * 16) * EIN;
#pragma unroll
                        for (int bj = 0; bj < 2; ++bj) {
                            const f32x4 v0 = acc[ai][bj][m][0], v1 = acc[ai][bj][m][1];
                            u32x4 w; w.x = cvt_pk_bf16(v0[0], v0[1]); w.y = cvt_pk_bf16(v0[2], v0[3]); w.z = cvt_pk_bf16(v1[0], v1[1]); w.w = cvt_pk_bf16(v1[2], v1[3]);
                            *(u32x4*)(rowp + bj * 32) = w;
                        }
                    }
            }
        } else {
            const int col0 = u.pn * 256 + wc * 32 + 8 * fq;
#pragma unroll
            for (int ai = 0; ai < 2; ++ai)
#pragma unroll
                for (int m = 0; m < 4; ++m) {
                    bf16_t* rowp = O + (size_t)(row0 + ai * 128 + m * 16) * ldc + col0;
#pragma unroll
                    for (int bj = 0; bj < 2; ++bj) {
                        f32x4 v0 = acc[ai][bj][m][0], v1 = acc[ai][bj][m][1];
                        if (presilu && u.pn < 4) {
#pragma unroll
                            for (int e2 = 0; e2 < 4; ++e2) { v0[e2] = silu_f(v0[e2]); v1[e2] = silu_f(v1[e2]); } }
                        u32x4 w; w.x = cvt_pk_bf16(v0[0], v0[1]); w.y = cvt_pk_bf16(v0[2], v0[3]); w.z = cvt_pk_bf16(v1[0], v1[1]); w.w = cvt_pk_bf16(v1[2], v1[3]);
                        *(u32x4*)(rowp + bj * 128) = w;
                    }
                }
        }
    }
};

__device__ __forceinline__ void tr_item(const float* __restrict__ W, int K, int N, bf16_t* __restrict__ WT, int dst_n0, int src_n0, int k0, LAS float* scr, int lane) {
#pragma unroll 8
    for (int i = 0; i < 32; ++i) { const int kk = 2 * i + (lane >> 5); scr[kk * 33 + (lane & 31)] = W[(size_t)(k0 + kk) * N + src_n0 + (lane & 31)]; }
    asm volatile("s_waitcnt lgkmcnt(0)" ::: "memory");
    const int c = lane & 7;
#pragma unroll
    for (int j = 0; j < 4; ++j) {
        const int n = (lane >> 3) + 8 * j; const LAS float* s = scr + (8 * c) * 33 + n;
        u32x4 o; o.x = cvt_pk_bf16(s[0 * 33], s[1 * 33]); o.y = cvt_pk_bf16(s[2 * 33], s[3 * 33]); o.z = cvt_pk_bf16(s[4 * 33], s[5 * 33]); o.w = cvt_pk_bf16(s[6 * 33], s[7 * 33]);
        *(u32x4*)(WT + (size_t)(dst_n0 + n) * K + k0 + 8 * c) = o;
    }
    asm volatile("s_waitcnt lgkmcnt(0)" ::: "memory");
}

__device__ __forceinline__ void prep_phase(const Params& p, LAS unsigned char* lds, int tid, int bx, int gdim) {
    const int lane = tid & 63, wave = tid >> 6;
    const int gw = bx * 8 + wave, ngw = gdim * 8;
    unsigned char* ws = p.ws;
    {
        LAS float* scr = (LAS float*)(lds + wave * 16384);
        constexpr int I_UP = 8 * 16 * 176, I_DN = 8 * 44 * 32, I_EI = 2 * 16 * 72, I_EO = 2 * 16 * 32, I_OI = 2 * 16 * 160, I_OO = 2 * 16 * 32;
        constexpr int NITEMS = I_UP + I_DN + I_EI + I_EO + I_OI + I_OO;
        for (int it = gw; it < NITEMS; it += ngw) {
            int r = it;
            if (r < I_UP) { const int mat = r / 2816, q = r % 2816, kb = q / 176, nb = q % 176, dn0 = nb * 32; const int src = ((dn0 >> 7) & 1) * FF + (dn0 >> 8) * 128 + (dn0 & 127);
                tr_item(p.ffn_up + (size_t)mat * DM * NUP, DM, NUP, (bf16_t*)(ws + WS_WUP) + (size_t)mat * NUP * DM, dn0, src, kb * 64, scr, lane); continue; }
            r -= I_UP;
            if (r < I_DN) { const int mat = r / 1408, q = r % 1408, kb = q / 32, nb = q % 32;
                tr_item(p.ffn_down + (size_t)mat * FF * DM, FF, DM, (bf16_t*)(ws + WS_WDN) + (size_t)mat * DM * FF, nb * 32, nb * 32, kb * 64, scr, lane); continue; }
            r -= I_DN;
            if (r < I_EI) { const int mat = r / 1152, q = r % 1152, kb = q / 72, nb = q % 72;
                const int dn0 = nb * 32, src = (4 * (dn0 >> 8) + ((dn0 >> 5) & 3)) * 64 + 32 * ((dn0 >> 7) & 1);
                tr_item(p.even_w_in + (size_t)mat * DM * EIN, DM, EIN, (bf16_t*)(ws + WS_WEIN) + (size_t)mat * EIN * DM, dn0, src, kb * 64, scr, lane); continue; }
            r -= I_EI;
            if (r < I_EO) { const int mat = r / 512, q = r % 512, kb = q / 32, nb = q % 32;
                tr_item(p.even_w_out + (size_t)mat * DM * DM, DM, DM, (bf16_t*)(ws + WS_WEOUT) + (size_t)mat * DM * DM, nb * 32, nb * 32, kb * 64, scr, lane); continue; }
            r -= I_EO;
            if (r < I_OI) { const int mat = r / 2560, q = r % 2560, kb = q / 160, nb = q % 160;
                tr_item(p.odd_w_in + (size_t)mat * DM * OIN, DM, OIN, (bf16_t*)(ws + WS_WOIN) + (size_t)mat * OIN * DM, nb * 32, nb * 32, kb * 64, scr, lane); continue; }
            r -= I_OI;
            { const int mat = r / 512, q = r % 512, kb = q / 32, nb = q % 32;
                tr_item(p.odd_w_out + (size_t)mat * DM * DM, DM, DM, (bf16_t*)(ws + WS_WOOUT) + (size_t)mat * DM * DM, nb * 32, nb * 32, kb * 64, scr, lane); }
        }
    }
    __syncthreads();
    {
        LAS float* sc = (LAS float*)lds;
        LAS float* red = (LAS float*)(lds + 65536);
        float* mod = (float*)(ws + WS_MOD);
        for (int i = tid; i < 16 * 1024; i += 512) { const int b = i >> 10, k = i & 1023; sc[k * 16 + b] = silu_f(p.c[i]); }
        __syncthreads();
        const int cl = tid & 127, kq = tid >> 7;
        for (int unit = bx; unit < 288; unit += gdim) {
            const int l = unit / 72, n0 = (unit % 72) * 128;
            const float* w = p.ada_w + (size_t)l * DM * NMOD + n0 + cl;
            float acc[16];
#pragma unroll
            for (int b = 0; b < 16; ++b) acc[b] = 0.f;
#pragma unroll 4
            for (int k = kq * 256; k < kq * 256 + 256; ++k) {
                const float wv = w[(size_t)k * NMOD];
                const LAS f32x4* s4 = (const LAS f32x4*)(sc + k * 16);
                const f32x4 s0 = s4[0], s1 = s4[1], s2 = s4[2], s3 = s4[3];
                acc[0] += s0[0] * wv; acc[1] += s0[1] * wv; acc[2] += s0[2] * wv; acc[3] += s0[3] * wv;
                acc[4] += s1[0] * wv; acc[5] += s1[1] * wv; acc[6] += s1[2] * wv; acc[7] += s1[3] * wv;
                acc[8] += s2[0] * wv; acc[9] += s2[1] * wv; acc[10] += s2[2] * wv; acc[11] += s2[3] * wv;
                acc[12] += s3[0] * wv; acc[13] += s3[1] * wv; acc[14] += s3[2] * wv; acc[15] += s3[3] * wv;
            }
#pragma unroll
            for (int b = 0; b < 16; ++b) red[(kq * 16 + b) * 128 + cl] = acc[b];
            __syncthreads();
            for (int o = tid; o < 2048; o += 512) {
                const int b = o >> 7, cc = o & 127;
                const float v = red[(0 * 16 + b) * 128 + cc] + red[(1 * 16 + b) * 128 + cc] + red[(2 * 16 + b) * 128 + cc] + red[(3 * 16 + b) * 128 + cc] + p.ada_b[(size_t)l * NMOD + n0 + cc];
                mod[((size_t)l * 16 + b) * NMOD + n0 + cc] = v;
            }
            __syncthreads();
        }
    }
}

__device__ __forceinline__ void norm_phase(const float* __restrict__ xin, const float* __restrict__ g, const float* __restrict__ modl, int shift_idx, bf16_t* __restrict__ h, int tid, int bx, int gdim) {
    const int lane = tid & 63, wave = tid >> 6;
    const int gw = bx * 8 + wave, ngw = gdim * 8;
    const int rpw = (M_TOK + ngw - 1) / ngw;
    int r0 = gw * rpw, r1 = r0 + rpw; if (r1 > M_TOK) r1 = M_TOK;
    f32x4 A[4], Bc[4]; int bcur = -1;
    for (int r = r0; r < r1;) {
        const int b = r / SEQ;
        if (b != bcur) {
            bcur = b;
#pragma unroll
            for (int j = 0; j < 4; ++j) {
                const int col = 4 * lane + 256 * j;
                const f32x4 gv = *(const f32x4*)(g + col), sc = *(const f32x4*)(modl + (size_t)b * NMOD + (shift_idx + 1) * 1024 + col), sh = *(const f32x4*)(modl + (size_t)b * NMOD + shift_idx * 1024 + col);
                A[j] = gv * (sc + 1.0f); Bc[j] = sh;
            }
        }
        const bool two = (r + 1 < r1) && ((r + 1) / SEQ == b);
        const f32x4* xr = (const f32x4*)(xin + (size_t)r * DM) + lane;
        const f32x4* xr2 = (const f32x4*)(xin + (size_t)(two ? r + 1 : r) * DM) + lane;
        f32x4 v[4], v2[4]; float ss = 0.f, ss2 = 0.f;
#pragma unroll
        for (int j = 0; j < 4; ++j) { v[j] = xr[64 * j]; v2[j] = xr2[64 * j]; }
#pragma unroll
        for (int j = 0; j < 4; ++j) { ss += (v[j][0] * v[j][0] + v[j][1] * v[j][1]) + (v[j][2] * v[j][2] + v[j][3] * v[j][3]); ss2 += (v2[j][0] * v2[j][0] + v2[j][1] * v2[j][1]) + (v2[j][2] * v2[j][2] + v2[j][3] * v2[j][3]); }
        ss = wave_sum(ss); ss2 = wave_sum(ss2);
        const float rstd = 1.0f / sqrtf(ss * (1.0f / DM) + EPS), rstd2 = 1.0f / sqrtf(ss2 * (1.0f / DM) + EPS);
        u32x2* o8 = (u32x2*)(h + (size_t)r * DM) + lane;
#pragma unroll
        for (int j = 0; j < 4; ++j) { const f32x4 y = v[j] * rstd * A[j] + Bc[j]; u32x2 w; w.x = cvt_pk_bf16(y[0], y[1]); w.y = cvt_pk_bf16(y[2], y[3]); o8[64 * j] = w; }
        if (two) {
            u32x2* o82 = (u32x2*)(h + (size_t)(r + 1) * DM) + lane;
#pragma unroll
            for (int j = 0; j < 4; ++j) { const f32x4 y = v2[j] * rstd2 * A[j] + Bc[j]; u32x2 w; w.x = cvt_pk_bf16(y[0], y[1]); w.y = cvt_pk_bf16(y[2], y[3]); o82[64 * j] = w; }
        }
        r += two ? 2 : 1;
    }
}

__device__ __forceinline__ void qknorm_phase(bf16_t* qkv, const float* __restrict__ qkg, int tid, int bx, int gdim) {
    const int lane = tid & 63, wave = tid >> 6;
    const int gw = bx * 8 + wave, ngw = gdim * 8;
    const int sub = lane >> 3, c8 = (lane & 7) * 8;
    for (int m = gw; m < M_TOK; m += ngw) {
        bf16_t* row = qkv + (size_t)m * EIN;
#pragma unroll
        for (int rd = 0; rd < 4; ++rd) {
            const int vi = rd * 8 + sub; const bool act = vi < 26;
            int col, gs; float qs = 1.0f;
            if (vi < 8) { col = vi * 64; gs = 0; qs = 0.125f * LOG2E; }
            else if (vi < 16) { col = 512 + (vi - 8) * 64; gs = 1; }
            else if (vi < 24) { col = 1536 + (vi - 16) * 64; gs = 2; qs = 0.125f * LOG2E; }
            else { col = 2048 + ((vi - 24) & 1) * 64; gs = 3; }
            u32x4 raw = (u32x4){0u, 0u, 0u, 0u};
            if (act) raw = *(const u32x4*)(row + col + c8);
            float f[8] = {bf_lo(raw.x), bf_hi(raw.x), bf_lo(raw.y), bf_hi(raw.y), bf_lo(raw.z), bf_hi(raw.z), bf_lo(raw.w), bf_hi(raw.w)};
            float ss = 0.f;
#pragma unroll
            for (int e = 0; e < 8; ++e) ss += f[e] * f[e];
            ss += __shfl_xor(ss, 1); ss += __shfl_xor(ss, 2); ss += __shfl_xor(ss, 4);
            const float rstd = qs / sqrtf(ss * (1.0f / 64.0f) + EPS);
            const f32x4 g0 = *(const f32x4*)(qkg + gs * 64 + c8), g1 = *(const f32x4*)(qkg + gs * 64 + c8 + 4);
            u32x4 w;
            w.x = cvt_pk_bf16(f[0] * rstd * g0[0], f[1] * rstd * g0[1]); w.y = cvt_pk_bf16(f[2] * rstd * g0[2], f[3] * rstd * g0[3]);
            w.z = cvt_pk_bf16(f[4] * rstd * g1[0], f[5] * rstd * g1[1]); w.w = cvt_pk_bf16(f[6] * rstd * g1[2], f[7] * rstd * g1[3]);
            if (act) *(u32x4*)(row + col + c8) = w;
        }
    }
}

constexpr int A_K0 = 0, A_KS = 8192, A_V0 = 16384, A_VS = 16384, A_LUT_OFF = 49152, A_Q_OFF = A_LUT_OFF + 4096;
__device__ __forceinline__ int t5_bucket(int rel) {
    const int n = rel < 0 ? -rel : rel; int b = rel > 0 ? 16 : 0;
    if (n < 8) b += n; else { const int v = 2 + (31 - __builtin_clz((unsigned)(n * n))); b += v < 15 ? v : 15; }
    return b;
}
__device__ __forceinline__ s16x4 tr16(const LAS unsigned char* p) {
    typedef short v4i16_t __attribute__((ext_vector_type(4)));
    return __builtin_bit_cast(s16x4, __builtin_amdgcn_ds_read_tr16_b64_v4i16((LAS v4i16_t*)p));
}
__device__ __forceinline__ int crow(int r, int hi) { return (r & 3) + 8 * (r >> 2) + 4 * hi; }
__device__ __forceinline__ u32x4 pair_swap(u32x2 a, u32x2 b) {
    const auto s0 = __builtin_amdgcn_permlane32_swap(a.x, b.x, false, false), s1 = __builtin_amdgcn_permlane32_swap(a.y, b.y, false, false);
    return (u32x4){s0[0], s1[0], s0[1], s1[1]};
}
template <int OFF> __device__ __forceinline__ s16x4 tr16a(unsigned a) { s16x4 r; asm volatile("ds_read_b64_tr_b16 %0, %1 offset:%2" : "=&v"(r) : "v"(a), "i"(OFF) : "memory"); return r; }
template <int DV, int H> __device__ __forceinline__ void v_half(unsigned a, s16x4 (&G)[4]) {
    constexpr int KS = (DV == 128) ? (H >> 1) : H, D0 = (DV == 128) ? 2 * (H & 1) : 0;
    G[0] = tr16a<D0 * 4096 + KS * 1024>(a); G[1] = tr16a<D0 * 4096 + KS * 1024 + 512>(a);
    G[2] = tr16a<(D0 + 1) * 4096 + KS * 1024>(a); G[3] = tr16a<(D0 + 1) * 4096 + KS * 1024 + 512>(a);
}
template <int N> __device__ __forceinline__ void v_wait4(s16x4 (&G)[4]) {
    asm volatile("s_waitcnt lgkmcnt(%4)" : "+v"(G[0]), "+v"(G[1]), "+v"(G[2]), "+v"(G[3]) : "i"(N) : "memory");
}
template <int DV, int H> __device__ __forceinline__ void v_mma(f32x16 (&o)[DV / 32], const s16x4 (&G)[4], const u32x4 (&pw)[4]) {
    constexpr int KS = (DV == 128) ? (H >> 1) : H, D0 = (DV == 128) ? 2 * (H & 1) : 0;
    const bf16x8 f0 = (bf16x8){G[0][0], G[0][1], G[0][2], G[0][3], G[1][0], G[1][1], G[1][2], G[1][3]}, f1 = (bf16x8){G[2][0], G[2][1], G[2][2], G[2][3], G[3][0], G[3][1], G[3][2], G[3][3]};
    o[D0] = __builtin_amdgcn_mfma_f32_32x32x16_bf16(f0, __builtin_bit_cast(bf16x8, pw[KS]), o[D0], 0, 0, 0);
    o[D0 + 1] = __builtin_amdgcn_mfma_f32_32x32x16_bf16(f1, __builtin_bit_cast(bf16x8, pw[KS]), o[D0 + 1], 0, 0, 0);
}
template <int DV, bool WIN>
__device__ __forceinline__ void attn_stream(LAS unsigned char* lds, const bf16_t* __restrict__ Kg, const bf16_t* __restrict__ Vg, const LAS unsigned char* qfp, int qw, int t0, int t1,
                                            float& m_run, float& l_run, f32x16 (&o)[DV / 32], int tid) {
    const int lane = tid & 63, r32 = lane & 31, hi = lane >> 5;
    const LAS float* lut = (const LAS float*)(lds + A_LUT_OFF);
    constexpr int VP = DV / 64, CPK = DV / 8;
    const int wid = __builtin_amdgcn_readfirstlane(tid >> 6);
    const unsigned koff = (unsigned)(lane * EIN + wid * 8);
    const LAS unsigned char* kb0 = lds + A_K0 + hi * 1024 + r32 * 16;
    const LAS unsigned char* vb0 = lds + A_V0 + ((lane >> 4) & 1) * 32 + (lane & 3) * 8 + (4 * hi + ((lane & 15) >> 2)) * 64;
#define ATT_DK(tt, sl) do { __builtin_amdgcn_global_load_lds((const unsigned*)(Kg + (size_t)(tt) * 64 * EIN + koff), (LAS unsigned*)(lds + A_K0 + (sl) * A_KS + wid * 1024), 16, 0, 0); } while (0)
#define ATT_DV(tt, sl) do { const bf16_t* vbase_ = Vg + (size_t)(tt) * 64 * EIN; \
    _Pragma("unroll") for (int j = 0; j < VP; ++j) { const int pc = wid + 8 * j; \
        __builtin_amdgcn_global_load_lds((const unsigned*)(vbase_ + (unsigned)((16 * (pc & 3) + (lane >> 2)) * EIN + (pc >> 2) * 32 + (lane & 3) * 8)), (LAS unsigned*)(lds + A_V0 + (sl) * A_VS + pc * 1024), 16, 0, 0); } } while (0)
#define ATT_QK4(FIRST0, FIRST1, P0, P1) do { _Pragma("unroll") for (int d0 = 0; d0 < 4; ++d0) { \
            const bf16x8 b0 = *(const LAS bf16x8*)(kbp_ + d0 * 2048), b1 = *(const LAS bf16x8*)(kbp_ + d0 * 2048 + 512); \
            const bf16x8 qv = *(const LAS bf16x8*)(qfp + d0 * 1024); \
            P0 = __builtin_amdgcn_mfma_f32_32x32x16_bf16(b0, qv, d0 == 0 ? (FIRST0) : P0, 0, 0, 0); \
            P1 = __builtin_amdgcn_mfma_f32_32x32x16_bf16(b1, qv, d0 == 0 ? (FIRST1) : P1, 0, 0, 0); } } while (0)
#define ATT_QKT(tt, P0, P1, CB) do { const int k0_ = (tt) * 64, relmin_ = k0_ - (qw + 31), relmax_ = k0_ + 63 - qw; \
        const LAS unsigned char* kbp_ = kb0 + (((tt) - t0) & 1) * A_KS; \
        if (!WIN && (relmin_ >= 91 || relmax_ <= -91)) { CB = (relmin_ >= 91) ? lut[224 + 128] : lut[224 - 128]; \
            const f32x16 z_ = {0.f, 0.f, 0.f, 0.f, 0.f, 0.f, 0.f, 0.f, 0.f, 0.f, 0.f, 0.f, 0.f, 0.f, 0.f, 0.f}; ATT_QK4(z_, z_, P0, P1); } \
        else { CB = 0.f; f32x16 i0_, i1_; const LAS float* lp_ = lut + (k0_ - qw - r32 + 4 * hi + 224); \
            _Pragma("unroll") for (int r = 0; r < 16; ++r) { i0_[r] = lp_[(r & 3) + 8 * (r >> 2)]; i1_[r] = lp_[(r & 3) + 8 * (r >> 2) + 32]; } \
            ATT_QK4(i0_, i1_, P0, P1); } } while (0)
#define ATT_SPV(tt, P0, P1, CB) do { \
        const float mref_ = m_run - CB; float rs_ = 0.f;     \
        _Pragma("unroll") for (int r = 0; r < 16; ++r) { P0[r] = ex2(P0[r] - mref_); P1[r] = ex2(P1[r] - mref_); rs_ += P0[r] + P1[r]; } \
        l_run += rs_; \
        u32x4 pw_[4]; \
        _Pragma("unroll") for (int k = 0; k < 2; ++k) { \
            pw_[k] = (u32x4){cvt_pk_bf16(P0[8 * k + 0], P0[8 * k + 1]), cvt_pk_bf16(P0[8 * k + 2], P0[8 * k + 3]), cvt_pk_bf16(P0[8 * k + 4], P0[8 * k + 5]), cvt_pk_bf16(P0[8 * k + 6], P0[8 * k + 7])}; \
            pw_[2 + k] = (u32x4){cvt_pk_bf16(P1[8 * k + 0], P1[8 * k + 1]), cvt_pk_bf16(P1[8 * k + 2], P1[8 * k + 3]), cvt_pk_bf16(P1[8 * k + 4], P1[8 * k + 5]), cvt_pk_bf16(P1[8 * k + 6], P1[8 * k + 7])}; } \
        const LAS unsigned char* vbp_ = vb0 + (((tt) - t0) & 1) * A_VS; \
        __builtin_amdgcn_sched_barrier(0); \
        { const unsigned va_ = (unsigned)(size_t)vbp_; s16x4 g0_[4], g1_[4], g2_[4];     \
          v_half<DV, 0>(va_, g0_); v_half<DV, 1>(va_, g1_); \
          v_half<DV, 2>(va_, g2_); v_wait4<8>(g0_); v_mma<DV, 0>(o, g0_, pw_); __builtin_amdgcn_sched_barrier(0); \
          v_half<DV, 3>(va_, g0_); v_wait4<8>(g1_); v_mma<DV, 1>(o, g1_, pw_); __builtin_amdgcn_sched_barrier(0); \
          if constexpr (DV == 128) { \
              v_half<DV, 4>(va_, g1_); v_wait4<8>(g2_); v_mma<DV, 2>(o, g2_, pw_); __builtin_amdgcn_sched_barrier(0); \
              v_half<DV, 5>(va_, g2_); v_wait4<8>(g0_); v_mma<DV, 3>(o, g0_, pw_); __builtin_amdgcn_sched_barrier(0); \
              v_half<DV, 6>(va_, g0_); v_wait4<8>(g1_); v_mma<DV, 4>(o, g1_, pw_); __builtin_amdgcn_sched_barrier(0); \
              v_half<DV, 7>(va_, g1_); v_wait4<8>(g2_); v_mma<DV, 5>(o, g2_, pw_); __builtin_amdgcn_sched_barrier(0); \
              v_wait4<4>(g0_); v_mma<DV, 6>(o, g0_, pw_); __builtin_amdgcn_sched_barrier(0); \
              v_wait4<0>(g1_); v_mma<DV, 7>(o, g1_, pw_); __builtin_amdgcn_sched_barrier(0); \
          } else { \
              v_wait4<4>(g2_); v_mma<DV, 2>(o, g2_, pw_); __builtin_amdgcn_sched_barrier(0); \
              v_wait4<0>(g0_); v_mma<DV, 3>(o, g0_, pw_); __builtin_amdgcn_sched_barrier(0); \
          } } } while (0)
#define ATT_STEP(tt, PA0, PA1, CBA, PB0, PB1, CBB) do { \
        asm volatile("s_waitcnt vmcnt(0)" ::: "memory"); __syncthreads(); \
        if ((tt) + 2 < t1) ATT_DK((tt) + 2, ((tt) - t0) & 1); \
        if ((tt) + 1 < t1) ATT_DV((tt) + 1, ((tt) + 1 - t0) & 1); \
        if ((tt) + 1 < t1 && !(WIN && (((tt) + 1) * 64 - (qw + 31) > 128 || ((tt) + 1) * 64 + 63 - qw < -128))) ATT_QKT((tt) + 1, PB0, PB1, CBB); \
        if (!(WIN && ((tt) * 64 - (qw + 31) > 128 || (tt) * 64 + 63 - qw < -128))) ATT_SPV(tt, PA0, PA1, CBA); } while (0)
    __syncthreads();
    ATT_DK(t0, 0); ATT_DV(t0, 0);
    if (t0 + 1 < t1) ATT_DK(t0 + 1, 1);
    asm volatile("s_waitcnt vmcnt(0)" ::: "memory"); __syncthreads();
    f32x16 pA0, pA1, pB0, pB1; float cbA = 0.f, cbB = 0.f;
    if (!(WIN && (t0 * 64 - (qw + 31) > 128 || t0 * 64 + 63 - qw < -128))) ATT_QKT(t0, pA0, pA1, cbA);
    for (int t = t0; t < t1; t += 2) {
        ATT_STEP(t, pA0, pA1, cbA, pB0, pB1, cbB);
        if (t + 1 < t1) ATT_STEP(t + 1, pB0, pB1, cbB, pA0, pA1, cbA);
    }
#undef ATT_DK
#undef ATT_DV
#undef ATT_QK4
#undef ATT_QKT
#undef ATT_SPV
#undef ATT_STEP
}
__device__ __forceinline__ void build_lut(LAS unsigned char* lds, const float* __restrict__ rel_bias, int head, bool win, int tid) {
    LAS float* lut = (LAS float*)(lds + A_LUT_OFF);
    __syncthreads();
    if (tid < 449) { const int rel = tid - 224; float v = rel_bias[t5_bucket(rel) * 12 + head] * LOG2E; if (win && (rel < -128 || rel > 128)) v = -INFINITY; lut[tid] = v; }
}

__device__ __forceinline__ void attn_phase(const Params& p, LAS unsigned char* lds, int layer, int tid, int bx0, int gdim) {
    const int lane = tid & 63, r32 = lane & 31, hi = lane >> 5, wid = tid >> 6;
    const int e = layer >> 1;
    const bf16_t* qkv = (const bf16_t*)(p.ws + WS_R1);
    bf16_t* yb = (bf16_t*)(p.ws + WS_Y);
    const int G = gdim, bx = bx0;
    const int vcu = (G % 8 == 0) ? (bx % 8) * (G / 8) + bx / 8 : bx;
    float mfix;
    { const float* qg = p.qk_norm_g + e * 256; float ga = fabsf(qg[lane]), gb = fabsf(qg[64 + lane]);
#pragma unroll
      for (int o2 = 1; o2 < 64; o2 <<= 1) { ga = fmaxf(ga, __shfl_xor(ga, o2)); gb = fmaxf(gb, __shfl_xor(gb, o2)); }
      mfix = 0.125f * LOG2E * 64.0f * ga * gb * 1.02f + 1.0f; }
    const float lam_init = 0.8f - 0.6f * expf(-0.3f * (float)layer);
    float lam;
    { const float* lp = p.diff_lambda + e * 256; const float s01 = wave_sum(lp[lane] * lp[64 + lane]), s23 = wave_sum(lp[128 + lane] * lp[192 + lane]); lam = expf(s01) - expf(s23) + lam_init; }
#ifndef NO_DIFF
    for (int unit = vcu; unit < 512; unit += G) {
        const int qb = unit & 7, h = (unit >> 3) & 3, b = unit >> 5;
        build_lut(lds, p.rel_bias, h, false, tid);
        const int qw = qb * 256 + wid * 32;
        const bf16_t* qkv_b = qkv + (size_t)b * SEQ * EIN;
        f32x4* stash = (f32x4*)(p.ws + WS_O1) + ((size_t)(bx * 8 + wid) * 16) * 64 + lane;
#pragma unroll 1
        for (int s = 0; s < 2; ++s) {
            LAS unsigned char* qfp = lds + A_Q_OFF + wid * 4096 + hi * 512 + r32 * 16;
#pragma unroll
            for (int d0 = 0; d0 < 4; ++d0) *(LAS bf16x8*)(qfp + d0 * 1024) = *(const bf16x8*)(qkv_b + (size_t)(qw + r32) * EIN + h * 128 + s * 64 + d0 * 16 + hi * 8);
            f32x16 o[4];
#pragma unroll
            for (int db = 0; db < 4; ++db)
#pragma unroll
                for (int r = 0; r < 16; ++r) o[db][r] = 0.f;
            float m_run = mfix, l_run = 0.f;
            attn_stream<128, false>(lds, qkv_b + 512 + h * 128 + s * 64, qkv_b + 1024 + h * 128, qfp, qw, 0, SEQ / 64, m_run, l_run, o, tid);
            const float lt = l_run + __shfl_xor(l_run, 32), inv = 1.0f / lt;
            if (s == 0) {
#pragma unroll
                for (int db = 0; db < 4; ++db)
#pragma unroll
                    for (int g4 = 0; g4 < 4; ++g4) stash[(db * 4 + g4) * 64] = (f32x4){o[db][4 * g4 + 0] * inv, o[db][4 * g4 + 1] * inv, o[db][4 * g4 + 2] * inv, o[db][4 * g4 + 3] * inv};
            } else {
                const float li = lam * inv; float ss = 0.f;
#pragma unroll
                for (int db = 0; db < 4; ++db)
#pragma unroll
                    for (int g4 = 0; g4 < 4; ++g4) { const f32x4 a = stash[(db * 4 + g4) * 64];
#pragma unroll
                        for (int e2 = 0; e2 < 4; ++e2) { const float v = a[e2] - o[db][4 * g4 + e2] * li; o[db][4 * g4 + e2] = v; ss += v * v; } }
                ss += __shfl_xor(ss, 32);
                const float rstd = (1.0f - lam_init) / sqrtf(ss * (1.0f / 128.0f) + EPS);
                const float* sg = p.diff_subln_g + e * 128;
                bf16_t* yrow = yb + (size_t)(b * SEQ + qw + r32) * DM + h * 128;
#pragma unroll
                for (int db = 0; db < 4; ++db) {
                    u32x2 wv[4];
#pragma unroll
                    for (int g4 = 0; g4 < 4; ++g4) {
                        const int dv = 32 * db + 8 * g4 + 4 * hi; const f32x4 gv = *(const f32x4*)(sg + dv);
                        wv[g4].x = cvt_pk_bf16(o[db][4 * g4 + 0] * rstd * gv[0], o[db][4 * g4 + 1] * rstd * gv[1]); wv[g4].y = cvt_pk_bf16(o[db][4 * g4 + 2] * rstd * gv[2], o[db][4 * g4 + 3] * rstd * gv[3]);
                    }
#pragma unroll
                    for (int kk = 0; kk < 2; ++kk) *(u32x4*)(yrow + 32 * db + 16 * kk + 8 * hi) = pair_swap(wv[2 * kk], wv[2 * kk + 1]);
                }
            }
        }
    }
#endif
}
__device__ __forceinline__ void attn_win_phase(const Params& p, LAS unsigned char* lds, int layer, int tid, int bx0, int gdim) {
    const int lane = tid & 63, r32 = lane & 31, hi = lane >> 5, wid = tid >> 6;
    const int e = layer >> 1;
    const bf16_t* qkv = (const bf16_t*)(p.ws + WS_R1);
    bf16_t* yb = (bf16_t*)(p.ws + WS_Y);
    const int G = gdim, bx = bx0;
    const int vcu = (G % 8 == 0) ? (bx % 8) * (G / 8) + bx / 8 : bx;
    float mfix;
    { const float* qg = p.qk_norm_g + e * 256 + 128; float ga = fabsf(qg[lane]), gb = fabsf(qg[64 + lane]);
#pragma unroll
      for (int o2 = 1; o2 < 64; o2 <<= 1) { ga = fmaxf(ga, __shfl_xor(ga, o2)); gb = fmaxf(gb, __shfl_xor(gb, o2)); }
      mfix = 0.125f * LOG2E * 64.0f * ga * gb * 1.02f + 1.0f; }
#ifndef NO_WIN
    for (int unit = vcu; unit < 1024; unit += G) {
        const int qb = unit & 7, hq = (unit >> 3) & 7, b = unit >> 6, kvh = hq >> 2;
        build_lut(lds, p.rel_bias, 4 + hq, true, tid);
        const int qw = qb * 256 + wid * 32;
        const bf16_t* qkv_b = qkv + (size_t)b * SEQ * EIN;
        LAS unsigned char* qfp = lds + A_Q_OFF + wid * 4096 + hi * 512 + r32 * 16;
#pragma unroll
        for (int d0 = 0; d0 < 4; ++d0) *(LAS bf16x8*)(qfp + d0 * 1024) = *(const bf16x8*)(qkv_b + (size_t)(qw + r32) * EIN + 1536 + hq * 64 + d0 * 16 + hi * 8);
        f32x16 o[2];
#pragma unroll
        for (int db = 0; db < 2; ++db)
#pragma unroll
            for (int r = 0; r < 16; ++r) o[db][r] = 0.f;
        float m_run = mfix, l_run = 0.5f * ex2(p.sink_logit[e * 8 + hq] * LOG2E - mfix);
        int t0 = (qb * 256 - 128) / 64, t1 = (qb * 256 + 384) / 64; if (qb == 0) t0 = 0; if (t1 > SEQ / 64) t1 = SEQ / 64;
        attn_stream<64, true>(lds, qkv_b + 2048 + kvh * 64, qkv_b + 2176 + kvh * 64, qfp, qw, t0, t1, m_run, l_run, o, tid);
        const float lt = l_run + __shfl_xor(l_run, 32), inv = 1.0f / lt;
        bf16_t* yrow = yb + (size_t)(b * SEQ + qw + r32) * DM + 512 + hq * 64;
#pragma unroll
        for (int db = 0; db < 2; ++db) {
            u32x2 wv[4];
#pragma unroll
            for (int g4 = 0; g4 < 4; ++g4) { wv[g4].x = cvt_pk_bf16(o[db][4 * g4 + 0] * inv, o[db][4 * g4 + 1] * inv); wv[g4].y = cvt_pk_bf16(o[db][4 * g4 + 2] * inv, o[db][4 * g4 + 3] * inv); }
#pragma unroll
            for (int kk = 0; kk < 2; ++kk) *(u32x4*)(yrow + 32 * db + 16 * kk + 8 * hi) = pair_swap(wv[2 * kk], wv[2 * kk + 1]);
        }
    }
#endif
}

constexpr int HC = 32;
constexpr int H_GL = 0, H_QS = H_GL + 32 * 145 * 4, H_KK = H_QS + 32 * 145 * 4, H_QT = H_KK + 32 * 145 * 4, H_KT = H_QT + 32 * 272, H_KH = H_KT + 32 * 272, H_VT = H_KH + 128 * 80,
              H_EGL = H_VT + 2 * 128 * 80, H_LB = H_EGL + 512, H_OP = H_LB + 512, H_END = H_OP + 8 * 1168 * 4;
static_assert(H_END <= LDS_BYTES - 64, "hgrn LDS");
__device__ __forceinline__ int pos16(int x) { return (x & ~12) | ((x & 4) << 1) | ((x & 8) >> 1); }
__device__ __forceinline__ void hgrn_phase(const Params& p, LAS unsigned char* lds, int layer, int tid, int bx, int gdim, bool dummy) {
    const int lane = tid & 63, wid = tid >> 6, r32 = lane & 31, hi = lane >> 5;
    bf16_t* qkv = (bf16_t*)(p.ws + WS_R1);
    LAS float* GL = (LAS float*)(lds + H_GL); LAS float* QS = (LAS float*)(lds + H_QS); LAS float* KK = (LAS float*)(lds + H_KK);
    LAS float* EGL = (LAS float*)(lds + H_EGL); LAS float* LB = (LAS float*)(lds + H_LB); LAS float* OP = (LAS float*)(lds + H_OP);
    for (int unit = bx; unit < 256; unit += gdim) {
        const int b = unit >> 4, h = (unit >> 1) & 7, dir = unit & 1;
        __syncthreads();
        if (tid < 128) {
            const float* cl = p.c_lower_bound + (size_t)dir * 4 * 1024 + h * 128 + tid;
            const float v0 = cl[0], v1 = cl[1024], v2 = cl[2048], v3 = cl[3072];
            const float mx = fmaxf(fmaxf(v0, v1), fmaxf(v2, v3));
            const float e0 = expf(v0 - mx), e1 = expf(v1 - mx), e2 = expf(v2 - mx), e3 = expf(v3 - mx), inv = 1.0f / (e0 + e1 + e2 + e3);
            float lb = 0.f; if (layer >= 1) lb += e1; if (layer >= 2) lb += e2; if (layer >= 3) lb += e3;
            LB[tid] = lb * inv;
        }
        __syncthreads();
        const int li = tid >> 4, ch0 = (tid & 15) * 8;
        const f32x4 lbA = *(const LAS f32x4*)(LB + ch0), lbB = *(const LAS f32x4*)(LB + ch0 + 4);
        bf16_t* base = qkv + (size_t)b * SEQ * OIN + h * 128 + ch0;
        const int fcol = 1024 + dir * 1024;
        const int dvb = wid & 3, dkh = wid >> 2;
        f32x16 S[2];
#pragma unroll
        for (int t = 0; t < 2; ++t)
#pragma unroll
            for (int r = 0; r < 16; ++r) S[t][r] = 0.f;
        u32x4 rq, rf, rv;
        { const int t = dir ? (SEQ - 1 - li) : li; const bf16_t* row = base + (size_t)t * OIN; rq = *(const u32x4*)row; rf = *(const u32x4*)(row + fcol); }
        const int tokv = tid & 31, chv = (tid >> 5) * 8;
        const bf16_t* vbase = qkv + (size_t)b * SEQ * OIN + 3072 + h * 128 + chv;
        { const int t = dir ? (SEQ - 1 - tokv) : tokv; rv = *(const u32x4*)(vbase + (size_t)t * OIN); }
        constexpr int NC = SEQ / HC;
        { const int vsel1 = 0; {
                const unsigned uq[4] = {rq.x, rq.y, rq.z, rq.w}, uf[4] = {rf.x, rf.y, rf.z, rf.w}, uv[4] = {rv.x, rv.y, rv.z, rv.w};
                const int psv = pos16(tokv);
#pragma unroll
                for (int e = 0; e < 8; ++e) {
                    const float q = (e & 1) ? bf_hi(uq[e >> 1]) : bf_lo(uq[e >> 1]), f = (e & 1) ? bf_hi(uf[e >> 1]) : bf_lo(uf[e >> 1]);
                    const float lbv = (e < 4) ? lbA[e & 3] : lbB[e & 3];
                    const float sg = sigm_f(f), sn = 1.0f - sg, fg = lbv + (1.0f - lbv) * sg;
                    GL[li * 145 + ch0 + (ch0 >> 3) + e] = __builtin_amdgcn_logf(fg);
                    QS[li * 145 + ch0 + (ch0 >> 3) + e] = q;
                    KK[li * 145 + ch0 + (ch0 >> 3) + e] = (1.0f - lbv) * sn;
                    const unsigned short vbits = (e & 1) ? (unsigned short)(uv[e >> 1] >> 16) : (unsigned short)(uv[e >> 1] & 0xffffu);
                    *(LAS unsigned short*)(lds + H_VT + vsel1 * (128 * 80) + (chv + e) * 80 + psv * 2) = vbits;
                }
            } }
        __syncthreads();
        { const int cpf = 1; { const int tt = (cpf) * HC + li, t = dir ? (SEQ - 1 - tt) : tt; const bf16_t* row = base + (size_t)t * OIN; rq = *(const u32x4*)row; rf = *(const u32x4*)(row + fcol);  const int ttv = (cpf) * HC + tokv, tv = dir ? (SEQ - 1 - ttv) : ttv; rv = *(const u32x4*)(vbase + (size_t)tv * OIN); } }
        {
                const int d = tid >> 2, tq = tid & 3;
                float G[8]; float run = 0.f;
#pragma unroll
                for (int j = 0; j < 8; ++j) { run += GL[(8 * tq + j) * 145 + d + (d >> 3)]; G[j] = run; }
                const float T0 = __shfl(run, (lane & ~3) + 0), T1 = __shfl(run, (lane & ~3) + 1), T2 = __shfl(run, (lane & ~3) + 2), T3 = __shfl(run, (lane & ~3) + 3);
                const float pre = (tq >= 1 ? T0 : 0.f) + (tq >= 2 ? T1 : 0.f) + (tq >= 3 ? T2 : 0.f), glast = (T0 + T1) + (T2 + T3);
                const int dp = pos16(d);
                const float egl = ex2(glast);
                float kh[8];
#pragma unroll
                for (int j = 0; j < 8; ++j) {
                    const float g = G[j] + pre, eg = ex2(g), ieg = ex2(-g), eh = egl * ieg;
                    const float qv = QS[(8 * tq + j) * 145 + d + (d >> 3)], kv = KK[(8 * tq + j) * 145 + d + (d >> 3)];
                    const unsigned qb = cvt_pk_bf16(qv * eg, 0.f), kb2 = cvt_pk_bf16(kv * ieg, 0.f);
                    *(LAS unsigned short*)(lds + H_QT + (8 * tq + j) * 272 + dp * 2) = (unsigned short)qb;
                    *(LAS unsigned short*)(lds + H_KT + (8 * tq + j) * 272 + dp * 2) = (unsigned short)kb2;
                    kh[j] = kv * eh;
                }
                u32x2 w0, w1; w0.x = cvt_pk_bf16(kh[0], kh[1]); w0.y = cvt_pk_bf16(kh[2], kh[3]); w1.x = cvt_pk_bf16(kh[4], kh[5]); w1.y = cvt_pk_bf16(kh[6], kh[7]);
                const int pb = (tq >> 1) * 16 + 4 * (tq & 1);
                *(LAS u32x2*)(lds + H_KH + d * 80 + pb * 2) = w0; *(LAS u32x2*)(lds + H_KH + d * 80 + (pb + 8) * 2) = w1;
                if (tq == 3) EGL[d] = egl;
            }
        __syncthreads();
        for (int c = 0; c < NC; ++c) {
            { const int vsel3 = c & 1; {
                f32x16 oacc;
#pragma unroll
                for (int r = 0; r < 16; ++r) oacc[r] = 0.f;
#pragma unroll
                for (int t = 0; t < 2; ++t)
#pragma unroll
                    for (int j = 0; j < 2; ++j) {
                        const u32x4 sa = (u32x4){cvt_pk_bf16(S[t][8 * j + 0], S[t][8 * j + 1]), cvt_pk_bf16(S[t][8 * j + 2], S[t][8 * j + 3]), cvt_pk_bf16(S[t][8 * j + 4], S[t][8 * j + 5]), cvt_pk_bf16(S[t][8 * j + 6], S[t][8 * j + 7])};
                        const bf16x8 qb = *(const LAS bf16x8*)(lds + H_QT + r32 * 272 + (32 * (2 * dkh + t) + 16 * j + 8 * hi) * 2);
                        oacc = __builtin_amdgcn_mfma_f32_32x32x16_bf16(__builtin_bit_cast(bf16x8, sa), qb, oacc, 0, 0, 0);
                    }
                if (dkh == 0) {
                    f32x16 at, at2;
#pragma unroll
                    for (int r = 0; r < 16; ++r) { at[r] = 0.f; at2[r] = 0.f; }
#pragma unroll
                    for (int ks = 0; ks < 8; ks += 2) {
                        const bf16x8 ka = *(const LAS bf16x8*)(lds + H_KT + r32 * 272 + (16 * ks + 8 * hi) * 2), qb = *(const LAS bf16x8*)(lds + H_QT + r32 * 272 + (16 * ks + 8 * hi) * 2);
                        const bf16x8 ka2 = *(const LAS bf16x8*)(lds + H_KT + r32 * 272 + (16 * ks + 16 + 8 * hi) * 2), qb2 = *(const LAS bf16x8*)(lds + H_QT + r32 * 272 + (16 * ks + 16 + 8 * hi) * 2);
                        at = __builtin_amdgcn_mfma_f32_32x32x16_bf16(ka, qb, at, 0, 0, 0);
                        at2 = __builtin_amdgcn_mfma_f32_32x32x16_bf16(ka2, qb2, at2, 0, 0, 0);
                    }
                    at += at2;
#pragma unroll
                    for (int r = 0; r < 16; ++r) if (crow(r, hi) > r32) at[r] = 0.f;
                    const u32x4 pw0 = (u32x4){cvt_pk_bf16(at[0], at[1]), cvt_pk_bf16(at[2], at[3]), cvt_pk_bf16(at[4], at[5]), cvt_pk_bf16(at[6], at[7])};
                    const u32x4 pw1 = (u32x4){cvt_pk_bf16(at[8], at[9]), cvt_pk_bf16(at[10], at[11]), cvt_pk_bf16(at[12], at[13]), cvt_pk_bf16(at[14], at[15])};
                    const bf16x8 va0 = *(const LAS bf16x8*)(lds + H_VT + vsel3 * (128 * 80) + (32 * dvb + r32) * 80 + (8 * hi) * 2);
                    const bf16x8 va1 = *(const LAS bf16x8*)(lds + H_VT + vsel3 * (128 * 80) + (32 * dvb + r32) * 80 + (16 + 8 * hi) * 2);
                    oacc = __builtin_amdgcn_mfma_f32_32x32x16_bf16(va0, __builtin_bit_cast(bf16x8, pw0), oacc, 0, 0, 0);
                    oacc = __builtin_amdgcn_mfma_f32_32x32x16_bf16(va1, __builtin_bit_cast(bf16x8, pw1), oacc, 0, 0, 0);
                }
#pragma unroll
                for (int g4 = 0; g4 < 4; ++g4) *(LAS f32x4*)(OP + wid * 1168 + r32 * 36 + 8 * g4 + 4 * hi) = (f32x4){oacc[4 * g4 + 0], oacc[4 * g4 + 1], oacc[4 * g4 + 2], oacc[4 * g4 + 3]};
#pragma unroll
                for (int t = 0; t < 2; ++t) {
                    const int dkb = 2 * dkh + t;
#pragma unroll
                    for (int g4 = 0; g4 < 4; ++g4) { const f32x4 eg = *(const LAS f32x4*)(EGL + 32 * dkb + 8 * g4 + 4 * hi);
#pragma unroll
                        for (int e2 = 0; e2 < 4; ++e2) S[t][4 * g4 + e2] *= eg[e2]; }
#pragma unroll
                    for (int js = 0; js < 2; ++js) {
                        const bf16x8 ka = *(const LAS bf16x8*)(lds + H_KH + (32 * dkb + r32) * 80 + (16 * js + 8 * hi) * 2), vb2 = *(const LAS bf16x8*)(lds + H_VT + vsel3 * (128 * 80) + (32 * dvb + r32) * 80 + (16 * js + 8 * hi) * 2);
                        S[t] = __builtin_amdgcn_mfma_f32_32x32x16_bf16(ka, vb2, S[t], 0, 0, 0);
                    }
                }
            } }
            if (c + 1 < NC) { const int vsel1 = (c + 1) & 1; {
                const unsigned uq[4] = {rq.x, rq.y, rq.z, rq.w}, uf[4] = {rf.x, rf.y, rf.z, rf.w}, uv[4] = {rv.x, rv.y, rv.z, rv.w};
                const int psv = pos16(tokv);
#pragma unroll
                for (int e = 0; e < 8; ++e) {
                    const float q = (e & 1) ? bf_hi(uq[e >> 1]) : bf_lo(uq[e >> 1]), f = (e & 1) ? bf_hi(uf[e >> 1]) : bf_lo(uf[e >> 1]);
                    const float lbv = (e < 4) ? lbA[e & 3] : lbB[e & 3];
                    const float sg = sigm_f(f), sn = 1.0f - sg, fg = lbv + (1.0f - lbv) * sg;
                    GL[li * 145 + ch0 + (ch0 >> 3) + e] = __builtin_amdgcn_logf(fg);
                    QS[li * 145 + ch0 + (ch0 >> 3) + e] = q;
                    KK[li * 145 + ch0 + (ch0 >> 3) + e] = (1.0f - lbv) * sn;
                    const unsigned short vbits = (e & 1) ? (unsigned short)(uv[e >> 1] >> 16) : (unsigned short)(uv[e >> 1] & 0xffffu);
                    *(LAS unsigned short*)(lds + H_VT + vsel1 * (128 * 80) + (chv + e) * 80 + psv * 2) = vbits;
                }
            } }
            __syncthreads();
            { const int cc4 = c; {
                const int ob = ch0 >> 5, dl = ch0 & 31;
                const f32x4 oa0 = *(const LAS f32x4*)(OP + ob * 1168 + li * 36 + dl), oa1 = *(const LAS f32x4*)(OP + ob * 1168 + li * 36 + dl + 4);
                const f32x4 ob0 = *(const LAS f32x4*)(OP + (ob + 4) * 1168 + li * 36 + dl), ob1 = *(const LAS f32x4*)(OP + (ob + 4) * 1168 + li * 36 + dl + 4);
                const f32x4 s0 = oa0 + ob0, s1 = oa1 + ob1;
                const float o8[8] = {s0[0], s0[1], s0[2], s0[3], s1[0], s1[1], s1[2], s1[3]};
                const int tt = cc4 * HC + li, t = dir ? (SEQ - 1 - tt) : tt;
                u32x4 w4; w4.x = cvt_pk_bf16(o8[0], o8[1]); w4.y = cvt_pk_bf16(o8[2], o8[3]); w4.z = cvt_pk_bf16(o8[4], o8[5]); w4.w = cvt_pk_bf16(o8[6], o8[7]);
                if (dummy) *(u32x4*)((bf16_t*)(p.ws + WS_Y) + (size_t)(unit * 32 + li) * 128 + ch0) = w4; else *(u32x4*)(base + (size_t)t * OIN + fcol) = w4;
            } }
            if (c + 2 < NC) { const int cpf = c + 2; { const int tt = (cpf) * HC + li, t = dir ? (SEQ - 1 - tt) : tt; const bf16_t* row = base + (size_t)t * OIN; rq = *(const u32x4*)row; rf = *(const u32x4*)(row + fcol);  const int ttv = (cpf) * HC + tokv, tv = dir ? (SEQ - 1 - ttv) : ttv; rv = *(const u32x4*)(vbase + (size_t)tv * OIN); } }
            if (c + 1 < NC) {
                const int d = tid >> 2, tq = tid & 3;
                float G[8]; float run = 0.f;
#pragma unroll
                for (int j = 0; j < 8; ++j) { run += GL[(8 * tq + j) * 145 + d + (d >> 3)]; G[j] = run; }
                const float T0 = __shfl(run, (lane & ~3) + 0), T1 = __shfl(run, (lane & ~3) + 1), T2 = __shfl(run, (lane & ~3) + 2), T3 = __shfl(run, (lane & ~3) + 3);
                const float pre = (tq >= 1 ? T0 : 0.f) + (tq >= 2 ? T1 : 0.f) + (tq >= 3 ? T2 : 0.f), glast = (T0 + T1) + (T2 + T3);
                const int dp = pos16(d);
                const float egl = ex2(glast);
                float kh[8];
#pragma unroll
                for (int j = 0; j < 8; ++j) {
                    const float g = G[j] + pre, eg = ex2(g), ieg = ex2(-g), eh = egl * ieg;
                    const float qv = QS[(8 * tq + j) * 145 + d + (d >> 3)], kv = KK[(8 * tq + j) * 145 + d + (d >> 3)];
                    const unsigned qb = cvt_pk_bf16(qv * eg, 0.f), kb2 = cvt_pk_bf16(kv * ieg, 0.f);
                    *(LAS unsigned short*)(lds + H_QT + (8 * tq + j) * 272 + dp * 2) = (unsigned short)qb;
                    *(LAS unsigned short*)(lds + H_KT + (8 * tq + j) * 272 + dp * 2) = (unsigned short)kb2;
                    kh[j] = kv * eh;
                }
                u32x2 w0, w1; w0.x = cvt_pk_bf16(kh[0], kh[1]); w0.y = cvt_pk_bf16(kh[2], kh[3]); w1.x = cvt_pk_bf16(kh[4], kh[5]); w1.y = cvt_pk_bf16(kh[6], kh[7]);
                const int pb = (tq >> 1) * 16 + 4 * (tq & 1);
                *(LAS u32x2*)(lds + H_KH + d * 80 + pb * 2) = w0; *(LAS u32x2*)(lds + H_KH + d * 80 + (pb + 8) * 2) = w1;
                if (tq == 3) EGL[d] = egl;
            }
            __syncthreads();
        }
    }
}
__device__ __forceinline__ void hgrn_combine_phase(const Params& p, int layer, int tid, int bx, int gdim) {
    const int lane = tid & 63, wave = tid >> 6;
    const int gw = bx * 8 + wave, ngw = gdim * 8;
    const bf16_t* qkv = (const bf16_t*)(p.ws + WS_R1);
    bf16_t* yb = (bf16_t*)(p.ws + WS_Y);
    const float* og = p.c_out_norm_g + (layer >> 1) * 128;
    for (int m = gw; m < M_TOK; m += ngw) {
        const bf16_t* row = qkv + (size_t)m * OIN;
#pragma unroll
        for (int j = 0; j < 2; ++j) {
            const int ch = j * 512 + lane * 8;
            const u32x4 a = *(const u32x4*)(row + 1024 + ch), bb = *(const u32x4*)(row + 2048 + ch), gg = *(const u32x4*)(row + 4096 + ch);
            float o[8] = {bf_lo(a.x) + bf_lo(bb.x), bf_hi(a.x) + bf_hi(bb.x), bf_lo(a.y) + bf_lo(bb.y), bf_hi(a.y) + bf_hi(bb.y), bf_lo(a.z) + bf_lo(bb.z), bf_hi(a.z) + bf_hi(bb.z), bf_lo(a.w) + bf_lo(bb.w), bf_hi(a.w) + bf_hi(bb.w)};
            const float g[8] = {bf_lo(gg.x), bf_hi(gg.x), bf_lo(gg.y), bf_hi(gg.y), bf_lo(gg.z), bf_hi(gg.z), bf_lo(gg.w), bf_hi(gg.w)};
            float ss = 0.f;
#pragma unroll
            for (int e = 0; e < 8; ++e) ss += o[e] * o[e];
            ss += __shfl_xor(ss, 1); ss += __shfl_xor(ss, 2); ss += __shfl_xor(ss, 4); ss += __shfl_xor(ss, 8);
            const float rstd = 1.0f / sqrtf(ss * (1.0f / 128.0f) + EPS);
            const f32x4 g0 = *(const f32x4*)(og + (ch & 127)), g1 = *(const f32x4*)(og + (ch & 127) + 4);
            u32x4 w;
            w.x = cvt_pk_bf16(o[0] * rstd * g0[0] * silu_f(g[0]), o[1] * rstd * g0[1] * silu_f(g[1])); w.y = cvt_pk_bf16(o[2] * rstd * g0[2] * silu_f(g[2]), o[3] * rstd * g0[3] * silu_f(g[3]));
            w.z = cvt_pk_bf16(o[4] * rstd * g1[0] * silu_f(g[4]), o[5] * rstd * g1[1] * silu_f(g[5])); w.w = cvt_pk_bf16(o[6] * rstd * g1[2] * silu_f(g[6]), o[7] * rstd * g1[3] * silu_f(g[7]));
            *(u32x4*)(yb + (size_t)m * DM + ch) = w;
        }
    }
}

#define XB_TMO      128
#define XB_XCNT(j)  (256  + 64 * (j))
#define XB_XSUB(j)  (1280 + 64 * (j))
#define XB_XGEN(j)  (2304 + 64 * (j))
#define XB_TOP      3328
#define XB_TOPGEN   3392
#define XCD_BAR_WORDS 3456
#define XB_SPIN_CAP (1u << 18)

__device__ __forceinline__ unsigned xb_ld(unsigned* p)              { return __hip_atomic_load(p, __ATOMIC_RELAXED, __HIP_MEMORY_SCOPE_AGENT); }
__device__ __forceinline__ unsigned xb_add(unsigned* p, unsigned v) { return __hip_atomic_fetch_add(p, v, __ATOMIC_RELAXED, __HIP_MEMORY_SCOPE_AGENT); }
__device__ __forceinline__ unsigned xb_xcc_id() { return (unsigned)__builtin_amdgcn_s_getreg((3 << 11) | 20) & 0xFu; }
#define XB_SPIN(cond, bar) do { unsigned _sp = 0; while (cond) { __builtin_amdgcn_s_sleep(1); \
    if ((++_sp & 255u) == 0u) { if (xb_ld(&(bar)[XB_TMO])) break; if (_sp > XB_SPIN_CAP) { atomicAdd(&(bar)[XB_TMO], 1u); break; } } } } while (0)

struct XcdBarrier {
    unsigned* bar; unsigned x;
    volatile LAS unsigned* st;
};

__device__ __forceinline__ XcdBarrier xcd_barrier_post(unsigned* bar, volatile LAS unsigned* st) {
    XcdBarrier b; b.bar = bar; b.x = xb_xcc_id(); b.st = st;
    if (threadIdx.x == 0) (void)xb_add(&bar[XB_XCNT(b.x)], 1u);
    return b;
}
__device__ __forceinline__ void xcd_barrier_complete(unsigned* bar, unsigned x, unsigned& nloc, unsigned& nx) {
    const unsigned G = gridDim.x * gridDim.y * gridDim.z;
    unsigned sum, cnt, mine, sp = 0u;
    for (;;) {
        sum = 0u; cnt = 0u; mine = 0u;
#pragma unroll
        for (unsigned j = 0; j < 16; ++j) { const unsigned c = xb_ld(&bar[XB_XCNT(j)]); sum += c; cnt += (c > 0u) ? 1u : 0u; mine = (j == x) ? c : mine; }
        if (sum == G) break;
        __builtin_amdgcn_s_sleep(1);
        if ((++sp & 255u) == 0u) { if (xb_ld(&bar[XB_TMO])) break; if (sp > XB_SPIN_CAP) { atomicAdd(&bar[XB_TMO], 1u); break; } }
    }
    nloc = mine > 0u ? mine : 1u; nx = cnt > 0u ? cnt : 1u;
}

__device__ __forceinline__ void xcd_barrier(const XcdBarrier& b) {
    asm volatile("s_waitcnt vmcnt(0)" ::: "memory");
    __syncthreads();
    if (threadIdx.x == 0) {
        unsigned* bar = b.bar;
        __builtin_amdgcn_s_waitcnt(0);
        unsigned nloc = b.st[0], nx = b.st[1];
        if (nloc == 0u) { xcd_barrier_complete(bar, b.x, nloc, nx); b.st[0] = nloc; b.st[1] = nx; }
        const unsigned old = xb_add(&bar[XB_XSUB(b.x)], 1u);
        const unsigned gen = old / nloc;
        if (old + 1u == (gen + 1u) * nloc) {
            __builtin_amdgcn_fence(__ATOMIC_RELEASE, "agent");
            asm volatile("s_waitcnt vmcnt(0)" ::: "memory");
            const unsigned og = xb_add(&bar[XB_TOP], 1u);
            const unsigned tg = og / nx;
            if (og + 1u == (tg + 1u) * nx) xb_add(&bar[XB_TOPGEN], 1u);
            else XB_SPIN(xb_ld(&bar[XB_TOPGEN]) == tg, bar);
            __builtin_amdgcn_fence(__ATOMIC_ACQUIRE, "agent");
            xb_add(&bar[XB_XGEN(b.x)], 1u);
            asm volatile("s_waitcnt vmcnt(0)" ::: "memory");
        } else {
            XB_SPIN(xb_ld(&bar[XB_XGEN(b.x)]) == gen, bar);
            __builtin_amdgcn_fence(__ATOMIC_ACQUIRE, "agent");
            asm volatile("s_waitcnt vmcnt(0)" ::: "memory");
        }
    }
    __syncthreads();
}

__global__ void __launch_bounds__(512) mega_fwd(Params p) {
    extern __shared__ __attribute__((aligned(16))) unsigned char lds_raw[];
    LAS unsigned char* lds = (LAS unsigned char*)lds_raw;
    cg::grid_group grid = cg::this_grid();
    volatile LAS unsigned* bst = (volatile LAS unsigned*)(lds + LDS_BYTES - 64);
    if (threadIdx.x < 4) bst[threadIdx.x] = 0u;
    __syncthreads();
    (void)xcd_barrier_post((unsigned*)(p.ws + WS_BAR), bst);
#define HB ((bf16_t*)(p.ws + WS_H))
#define YB ((bf16_t*)(p.ws + WS_Y))
#define R1 ((bf16_t*)(p.ws + WS_R1))
    int prep_cnt = 0;
#pragma unroll 1
    for (int ph = p.ph_lo; ph < p.ph_hi; ++ph) {
        if (ph > 0 && (((ph - 1) / 11) & 1) == 0 && (ph - 1) % 11 == 5) continue;
        int tid = threadIdx.x, bx = blockIdx.x; asm volatile("" : "+v"(tid)); asm volatile("" : "+s"(bx)); int gdim = gridDim.x; asm volatile("" : "+s"(gdim));
        typedef const __attribute__((address_space(4))) Params* kparg_t;
        kparg_t kq = (kparg_t)__builtin_amdgcn_kernarg_segment_ptr(); asm volatile("" : "+s"(kq));
        Params P;
#if defined(__HIP_DEVICE_COMPILE__)
        P = *kq;
#else
        P = p;
#endif
        if (ph > p.ph_lo) { if (p.ph_lo < 0) grid.sync(); else { XcdBarrier xbar; xbar.bar = (unsigned*)(P.ws + WS_BAR); xbar.x = xb_xcc_id(); xbar.st = (volatile LAS unsigned*)(lds + LDS_BYTES - 64);
            for (int rep = 0; rep < PROBE_SYNC_REP; ++rep) xcd_barrier(xbar); } }
        if (ph == 0) {
#ifndef NO_PREP
            for (int rep = 0; rep < PROBE_PREP_REP; ++rep) prep_phase(P, lds, tid, bx, gdim);
#endif
            continue; }
        const int l = (ph - 1) / 11, s = (ph - 1) % 11;
        const float* modl = (const float*)(P.ws + WS_MOD) + (size_t)l * 16 * NMOD;
        if (s == 0 || s == 3 || s == 8) {
            const int j = (s == 0) ? 0 : (s == 3 ? 1 : 2);
            const float* xin = (l == 0 && s == 0) ? P.x : P.out;
            for (int rep = 0; rep < PROBE_NORM_REP; ++rep) norm_phase(xin, P.norm_g + (size_t)(l * 3 + j) * DM, modl, 3 * j, HB, tid, bx, gdim);
        } else if (s == 1 || s == 9 || s == 2 || s == 10 || s == 7 || s == 4) {
            pg8::Gemm g; EpiMulti E; E.O = R1; E.ldc = FF; E.base = P.out; E.out = P.out; E.gate = modl; E.coef = 1.0f; E.presilu = 0;
            if (s == 1 || s == 9) {
                const int fi = (s == 1) ? 0 : 1;
                g = pg8::Gemm{HB, (const bf16_t*)(P.ws + WS_WUP) + (size_t)(l * 2 + fi) * NUP * DM, M_TOK, NUP, DM}; E.mode = 0;
            } else if (s == 7) {
                const bf16_t* w = (l & 1) ? (const bf16_t*)(P.ws + WS_WOOUT) + (size_t)(l >> 1) * DM * DM : (const bf16_t*)(P.ws + WS_WEOUT) + (size_t)(l >> 1) * DM * DM;
                g = pg8::Gemm{YB, w, M_TOK, DM, DM}; E.mode = 1; E.gate = modl + 5 * 1024; E.coef = 1.0f;
            } else if (s == 4) {
                const int N = (l & 1) ? OIN : EIN;
                const bf16_t* w = (l & 1) ? (const bf16_t*)(P.ws + WS_WOIN) + (size_t)(l >> 1) * OIN * DM : (const bf16_t*)(P.ws + WS_WEIN) + (size_t)(l >> 1) * EIN * DM;
                g = pg8::Gemm{HB, w, M_TOK, N, DM}; E.mode = (l & 1) ? 2 : 3; E.presilu = (l & 1); E.ldc = N; E.gate = P.qk_norm_g + (size_t)(l >> 1) * 256;
            } else {
                const int fi = (s == 2) ? 0 : 1;
                g = pg8::Gemm{R1, (const bf16_t*)(P.ws + WS_WDN) + (size_t)(l * 2 + fi) * DM * FF, M_TOK, DM, FF}; E.mode = 1; E.gate = modl + (fi ? 8 : 2) * 1024; E.coef = 0.5f;
                if (l == 0 && s == 2) E.base = P.x;
            }
            if (PROBE_DOWN_REP > 1 && (s == 2 || s == 10) && prep_cnt + 1 < PROBE_DOWN_REP) E.out = (float*)(P.ws + WS_H);
            if (PROBE_OUT_REP > 1 && s == 7 && prep_cnt + 1 < PROBE_OUT_REP) E.out = (float*)(P.ws + WS_R1);
            pg8::StaticOrder S; S.init(g.M, g.N, gdim, bx);
#ifndef NO_G1
            pg8::gemm_phase<EpiMulti, pg8::StaticOrder, false>(lds, g, S, E, nullptr, tid);
            if (PROBE_UP_REP > 1 && (s == 1 || s == 9)) { if (prep_cnt + 1 < PROBE_UP_REP) { ++prep_cnt; --ph; } else prep_cnt = 0; }
            if (PROBE_DOWN_REP > 1 && (s == 2 || s == 10)) { if (prep_cnt + 1 < PROBE_DOWN_REP) { ++prep_cnt; --ph; } else prep_cnt = 0; }
            if (PROBE_OUT_REP > 1 && s == 7) { if (prep_cnt + 1 < PROBE_OUT_REP) { ++prep_cnt; --ph; } else prep_cnt = 0; }
            if (PROBE_IN_REP > 1 && s == 4) { if (prep_cnt + 1 < PROBE_IN_REP) { ++prep_cnt; --ph; } else prep_cnt = 0; }
#endif
        } else if (s == 5) {
            if (l & 1) {
#ifndef NO_HGRN
                for (int rep = 0; rep < PROBE_HGRN_REP; ++rep) hgrn_phase(P, lds, l, tid, bx, gdim, rep + 1 < PROBE_HGRN_REP);
#endif
            } else {
#ifndef NO_QKN
                qknorm_phase(R1, P.qk_norm_g + (size_t)(l >> 1) * 256, tid, bx, gdim);
#endif
            }
        } else {
            if (l & 1) {
#ifndef NO_COMB
                hgrn_combine_phase(P, l, tid, bx, gdim);
#endif
            } else {
#ifndef NO_ATTN
                for (int rep = 0; rep < PROBE_ATT_REP; ++rep) {
                attn_phase(P, lds, l, tid, bx, gdim);
                { int tid2 = tid; asm volatile("" : "+v"(tid2)); attn_win_phase(P, lds, l, tid2, bx, gdim); }
                }
#endif
            }
        }
    }
#undef HB
#undef YB
#undef R1
}

#ifndef MK_PER_PHASE
#define MK_PER_PHASE 0
#endif
extern "C" void kernel_launch(void* const* d_in, const int* in_sizes, int n_in, void* d_out, int out_size, void* d_ws, size_t ws_size, hipStream_t stream) {
    static int grid = 0;
    if (grid == 0) {
        if (n_in != 18 || out_size != M_TOK * DM || ws_size < WS_END) { fprintf(stderr, "kernel_launch: unexpected shapes (n_in %d out %d ws %zu need %zu)\n", n_in, out_size, ws_size, (size_t)WS_END); grid = -1; return; }
        int dev = 0, cus = 0, per_cu = 0;
        hipGetDevice(&dev);
        hipDeviceGetAttribute(&cus, hipDeviceAttributeMultiprocessorCount, dev);
        if (hipFuncSetAttribute((const void*)mega_fwd, hipFuncAttributeMaxDynamicSharedMemorySize, LDS_BYTES) != hipSuccess) { fprintf(stderr, "kernel_launch: hipFuncSetAttribute failed\n"); grid = -1; return; }
        if (hipOccupancyMaxActiveBlocksPerMultiprocessor(&per_cu, (const void*)mega_fwd, 512, LDS_BYTES) != hipSuccess || per_cu < 1) { fprintf(stderr, "kernel_launch: occupancy query says %d\n", per_cu); per_cu = 1; }
        (void)hipGetLastError();
        grid = cus * 1;
    }
    if (grid < 0) return;
    Params p{};
    const float** pp = (const float**)&p;
    for (int i = 0; i < 18; ++i) pp[i] = (const float*)d_in[i];
    p.out = (float*)d_out; p.ws = (unsigned char*)d_ws;
#if MK_PER_PHASE
    for (int ph = 0; ph < N_PHASES; ++ph) {
        p.ph_lo = ph; p.ph_hi = ph + 1;
        hipLaunchKernelGGL(mega_fwd, dim3(grid), dim3(512), LDS_BYTES, stream, p);
    }
#else
    p.ph_lo = 0; p.ph_hi = N_PHASES;
    if (hipMemsetAsync((unsigned char*)d_ws + WS_BAR, 0, 16384, stream) != hipSuccess) { fprintf(stderr, "kernel_launch: memset of barrier words failed\n"); return; }
    void* args[] = {&p};
    hipError_t e = hipLaunchCooperativeKernel((const void*)mega_fwd, dim3(grid), dim3(512), args, LDS_BYTES, stream);
    if (e != hipSuccess) fprintf(stderr, "cooperative launch failed: %s (grid %d)\n", hipGetErrorString(e), grid);
#endif
}
```
